# Optimizing an MI355X kernel written in HIP

```python
import jax, jax.numpy as jnp
from jax import lax
import numpy as np

D_MODEL = 1024
BATCH = 8
SEQ = 4096
DEPTH = 2

CHUNK = 64
N_MIXERS = 2
N_A = (DEPTH + 1) // 2
N_B = DEPTH // 2
SHORT_CONV_WIDTH = 3
CONFORMER_CONV_WIDTH = 31
D_FF = ((8 * D_MODEL // 3 + 255) // 256) * 256
RMS_EPS = 1e-6
LN_EPS = 1e-5

kernel_name = "hybrid_shortconv_conformer_conv_encoder"


def rms_norm(x, g):
    xf = x.astype(jnp.float32)
    y = xf * lax.rsqrt(jnp.mean(xf * xf, axis=-1, keepdims=True) + RMS_EPS)
    return (y * g.astype(jnp.float32)).astype(x.dtype)


def layer_norm(x, g, b):
    xf = x.astype(jnp.float32)
    mu = jnp.mean(xf, axis=-1, keepdims=True)
    var = jnp.mean(jnp.square(xf - mu), axis=-1, keepdims=True)
    y = (xf - mu) * lax.rsqrt(var + LN_EPS)
    return (y * g.astype(jnp.float32) + b.astype(jnp.float32)).astype(x.dtype)


def causal_depthwise_conv(x, w):
    k = w.shape[0]
    return lax.conv_general_dilated(
        x, w[:, None, :].astype(x.dtype), window_strides=(1,),
        padding=[(k - 1, 0)], dimension_numbers=("NWC", "WIO", "NWC"),
        feature_group_count=x.shape[-1])


def short_gated_conv(h, w_in, w_conv, w_out):
    bcv = jnp.einsum("bsd,de->bse", h, w_in)
    gate_b, gate_c, v = jnp.split(bcv, 3, axis=-1)
    y = gate_b * causal_depthwise_conv(gate_c * v, w_conv)
    return jnp.einsum("bsd,de->bse", y, w_out)


def conformer_conv_module(h, w_pw1, b_pw1, w_dw, b_dw, ln_g, ln_b, w_pw2, b_pw2):
    u = jnp.einsum("bsd,de->bse", h, w_pw1) + b_pw1
    a, g = jnp.split(u, 2, axis=-1)
    u = a * jax.nn.sigmoid(g)
    u = causal_depthwise_conv(u, w_dw) + b_dw
    u = jax.nn.silu(layer_norm(u, ln_g, ln_b))
    return jnp.einsum("bsd,de->bse", u, w_pw2) + b_pw2


def swiglu(h, w_gate, w_up, w_down):
    gu = jax.nn.silu(jnp.einsum("bsd,df->bsf", h, w_gate)) * jnp.einsum("bsd,df->bsf", h, w_up)
    return jnp.einsum("bsf,fd->bsd", gu, w_down)


def setup_inputs(seed: int = 0) -> dict:
    key = jax.random.key(seed)
    ks = jax.random.split(key, 24)
    D, F = D_MODEL, D_FF
    nrm = lambda k, shape, fan_in: jax.random.normal(k, shape, jnp.float32) * (fan_in ** -0.5)
    gain = lambda k, shape: 1.0 + 0.02 * jax.random.normal(k, shape, jnp.float32)
    small = lambda k, shape: 0.02 * jax.random.normal(k, shape, jnp.float32)
    return {
        "x": jax.random.normal(ks[0], (BATCH, SEQ, D), jnp.float32),
        "a_norm": gain(ks[1], (N_A, D)),
        "a_w_in": nrm(ks[2], (N_A, D, 3 * D), D),
        "a_conv": nrm(ks[3], (N_A, SHORT_CONV_WIDTH, D), SHORT_CONV_WIDTH),
        "a_w_out": nrm(ks[4], (N_A, D, D), D),
        "b_norm": gain(ks[5], (N_B, D)),
        "b_w_pw1": nrm(ks[6], (N_B, D, 2 * D), D),
        "b_b_pw1": small(ks[7], (N_B, 2 * D)),
        "b_conv": nrm(ks[8], (N_B, CONFORMER_CONV_WIDTH, D), CONFORMER_CONV_WIDTH),
        "b_b_conv": small(ks[9], (N_B, D)),
        "b_ln_g": gain(ks[10], (N_B, D)),
        "b_ln_b": small(ks[11], (N_B, D)),
        "b_w_pw2": nrm(ks[12], (N_B, D, D), D),
        "b_b_pw2": small(ks[13], (N_B, D)),
        "ffn_norm": gain(ks[14], (DEPTH, D)),
        "ffn_w_gate": nrm(ks[15], (DEPTH, D, F), D),
        "ffn_w_up": nrm(ks[16], (DEPTH, D, F), D),
        "ffn_w_down": nrm(ks[17], (DEPTH, F, D), F),
        "final_norm": gain(ks[18], (D,)),
    }


def reference(x, a_norm, a_w_in, a_conv, a_w_out,
              b_norm, b_w_pw1, b_b_pw1, b_conv, b_b_conv, b_ln_g, b_ln_b, b_w_pw2, b_b_pw2,
              ffn_norm, ffn_w_gate, ffn_w_up, ffn_w_down, final_norm):
    h = x
    for i in range(DEPTH):
        j = i // N_MIXERS
        if i % N_MIXERS == 0:
            h = h + short_gated_conv(rms_norm(h, a_norm[j]), a_w_in[j], a_conv[j], a_w_out[j])
        else:
            h = h + conformer_conv_module(
                rms_norm(h, b_norm[j]), b_w_pw1[j], b_b_pw1[j], b_conv[j], b_b_conv[j],
                b_ln_g[j], b_ln_b[j], b_w_pw2[j], b_b_pw2[j])
        h = h + swiglu(rms_norm(h, ffn_norm[i]), ffn_w_gate[i], ffn_w_up[i], ffn_w_down[i])
    return rms_norm(h, final_norm)
```

```cpp
#include <hip/hip_runtime.h>
#include <hip/hip_cooperative_groups.h>
#include <cstdio>
#include <cstdint>
namespace cg = cooperative_groups;
#ifndef MK_PER_PHASE
#define MK_PER_PHASE 1
#endif
namespace pg8 {
#define PG8_LAS __attribute__((address_space(3)))
typedef unsigned short bf16_t;
typedef short bf16x8 __attribute__((ext_vector_type(8)));
typedef float f32x4 __attribute__((ext_vector_type(4)));
typedef unsigned u32x4 __attribute__((ext_vector_type(4)));
constexpr int BM = 256, BK = 64, HALF = 128, HTB = HALF * BK * 2  , STAGE_BYTES = 8 * HTB, NXCD = 8, WGM = 8;

__host__ __device__ __forceinline__ int lds_byte(int r, int c) { const int st = (r >> 4) * 2 + (c >> 5), rr = r & 15, cc = c & 31, ob = rr * 64 + cc * 2; return st * 1024 + (ob ^ (((ob >> 9) & 1) << 5)); }
__host__ __device__ __forceinline__ void stage_rc(int b, int& R, int& C) { const int st = b / 1024, sb = b % 1024, swz = sb ^ (((sb >> 9) & 1) << 5); R = (st >> 1) * 16 + swz / 64; C = (st & 1) * 32 + (swz % 64) / 2; }
__host__ __device__ __forceinline__ int perm32(int rho) { const int n = rho >> 4, i = rho & 15; return 8 * (i >> 2) + 4 * n + (i & 3); }

struct Unit { int pm, pn; };
struct Gemm { const bf16_t* A; const bf16_t* Bt; int M, N, K; };

struct StaticOrder {
    int nM, nN, nwg, G, c;
    __host__ __device__ void init(int M, int N, int G_, int c_) { nM = M / BM; nN = N / BM; nwg = nM * nN; G = G_; c = c_; }
    __host__ __device__ bool next(int i, Unit& u) const {
        const long L = (long)i * G + c; if (L >= nwg) return false;
        int wgid = (int)L; { const int q = nwg / NXCD, r = nwg % NXCD, xcd = wgid % NXCD, off = wgid / NXCD; wgid = (xcd < r ? xcd * (q + 1) : r * (q + 1) + (xcd - r) * q) + off; }
        const int nig = WGM * nN, gid = wgid / nig, fm = gid * WGM, gsz = (nM - fm) < WGM ? (nM - fm) : WGM;
        u.pm = fm + ((wgid % nig) % gsz); u.pn = (wgid % nig) / gsz; return true;
    }
    __device__ __forceinline__ void a_ready(const Unit&) const {}
    __device__ __forceinline__ void done(const Unit&) const {}
};

__device__ __forceinline__ unsigned cvt_pk_bf16(float lo, float hi) { unsigned r; asm volatile("v_cvt_pk_bf16_f32 %0, %1, %2" : "=v"(r) : "v"(lo), "v"(hi)); return r; }
typedef float f32x2 __attribute__((ext_vector_type(2)));
__device__ __forceinline__ float sigmoid_f(float x) { return __builtin_amdgcn_rcpf(1.0f + __builtin_amdgcn_exp2f(-1.4426950408889634f * x)); }
constexpr int NSTAT = 16;
__device__ __forceinline__ void load_rscale(const float* stats, int row0, int fq, float (&rs)[2][4]) {
#pragma unroll
    for (int ai = 0; ai < 2; ++ai)
#pragma unroll
        for (int m = 0; m < 4; ++m) {
            const f32x4 p = *(const f32x4*)(stats + (size_t)(row0 + ai * HALF + m * 16) * NSTAT + fq * 4);
            float s = (p[0] + p[1]) + (p[2] + p[3]); s += __shfl_xor(s, 16); s += __shfl_xor(s, 32);
            rs[ai][m] = 1.0f / sqrtf(s * (1.0f / 1024.0f) + 1e-6f);
        }
}
__device__ __forceinline__ u32x4 pack8(const f32x4 v0, const f32x4 v1) { u32x4 w; w.x = cvt_pk_bf16(v0[0], v0[1]); w.y = cvt_pk_bf16(v0[2], v0[3]); w.z = cvt_pk_bf16(v1[0], v1[1]); w.w = cvt_pk_bf16(v1[2], v1[3]); return w; }
template <int MODE> struct EpiPair {
    static constexpr bool PERM = true, AFTER_DRAIN = false;
    bf16_t* O; int ldc; bf16_t* O2; const float* stats; const float* bias;
    __device__ __forceinline__ void operator()(const f32x4 (&acc)[2][2][4][2], const Unit& u, int wr, int wc, int fr, int fq) const {
        const int row0 = u.pm * BM + wr * 64 + fr, cw = wc * 32 + 8 * fq;
        float rs[2][4]; load_rscale(stats, row0, fq, rs);
        if (MODE == 2 && u.pn >= 8) {
#pragma unroll
            for (int ai = 0; ai < 2; ++ai)
#pragma unroll
                for (int m = 0; m < 4; ++m) { const float r = rs[ai][m]; bf16_t* rowp = O2 + (size_t)(row0 + ai * HALF + m * 16) * 1024 + (u.pn - 8) * BM + cw;
#pragma unroll
                    for (int bj = 0; bj < 2; ++bj) *(u32x4*)(rowp + bj * HALF) = pack8(acc[ai][bj][m][0] * r, acc[ai][bj][m][1] * r); }
            return;
        }
        f32x4 bp[2], bq[2];
#pragma unroll
        for (int n = 0; n < 2; ++n) { bp[n] = (f32x4){0.f, 0.f, 0.f, 0.f}; bq[n] = bp[n]; if (MODE == 1) { bp[n] = *(const f32x4*)(bias + u.pn * HALF + cw + 4 * n); bq[n] = *(const f32x4*)(bias + 1024 + u.pn * HALF + cw + 4 * n); } }
#pragma unroll
        for (int ai = 0; ai < 2; ++ai)
#pragma unroll
            for (int m = 0; m < 4; ++m) { const float r = rs[ai][m]; bf16_t* rowp = O + (size_t)(row0 + ai * HALF + m * 16) * ldc + u.pn * HALF + cw;
                f32x4 o[2];
#pragma unroll
                for (int n = 0; n < 2; ++n) { const f32x4 p = acc[ai][0][m][n] * r + bp[n], q = acc[ai][1][m][n] * r + bq[n];
#pragma unroll
                    for (int e = 0; e < 4; ++e) {
                        if (MODE == 0) o[n][e] = p[e] * sigmoid_f(p[e]) * q[e];
                        else if (MODE == 1) o[n][e] = p[e] * sigmoid_f(q[e]);
                        else o[n][e] = p[e] * q[e]; } }
                *(u32x4*)rowp = pack8(o[0], o[1]); }
    }
};
struct EpiRes {
    static constexpr bool PERM = true, AFTER_DRAIN = false;
    const float* base; float* out; bf16_t* hb; float* stats; const float* bias;
    __device__ __forceinline__ void operator()(const f32x4 (&acc)[2][2][4][2], const Unit& u, int wr, int wc, int fr, int fq) const {
        const int row0 = u.pm * BM + wr * 64 + fr, col0 = u.pn * BM + wc * 32 + 8 * fq;
        f32x4 bv[2][2];
#pragma unroll
        for (int bj = 0; bj < 2; ++bj)
#pragma unroll
            for (int n = 0; n < 2; ++n) bv[bj][n] = bias ? *(const f32x4*)(bias + col0 + bj * HALF + 4 * n) : (f32x4){0.f, 0.f, 0.f, 0.f};
#pragma unroll
        for (int ai = 0; ai < 2; ++ai)
#pragma unroll
            for (int m = 0; m < 4; ++m) { const int row = row0 + ai * HALF + m * 16; const size_t off = (size_t)row * 1024 + col0; float ss = 0.f;
#pragma unroll
                for (int bj = 0; bj < 2; ++bj) {
                    const f32x4 b0 = *(const f32x4*)(base + off + bj * HALF), b1 = *(const f32x4*)(base + off + bj * HALF + 4);
                    const f32x4 v0 = b0 + acc[ai][bj][m][0] + bv[bj][0], v1 = b1 + acc[ai][bj][m][1] + bv[bj][1];
                    *(f32x4*)(out + off + bj * HALF) = v0; *(f32x4*)(out + off + bj * HALF + 4) = v1;
                    ss += (v0[0] * v0[0] + v0[1] * v0[1]) + (v0[2] * v0[2] + v0[3] * v0[3]) + (v1[0] * v1[0] + v1[1] * v1[1]) + (v1[2] * v1[2] + v1[3] * v1[3]);
                    if (hb) *(u32x4*)(hb + off + bj * HALF) = pack8(v0, v1); }
                if (stats) { ss += __shfl_xor(ss, 16); ss += __shfl_xor(ss, 32); if (fq == 0) stats[(size_t)row * NSTAT + u.pn * 4 + wc] = ss; } }
    }
};
template <class Epi, class Sched, bool ALIGN_EPI = false, bool SP2 = false>
__device__ __forceinline__ void gemm_phase(PG8_LAS unsigned char* lds, const Gemm g, const Sched& S, const Epi& E) {
    const int tid = threadIdx.x, wid = __builtin_amdgcn_readfirstlane(tid >> 6), lane = tid & 63, wr = wid >> 2, wc = wid & 3, fr = lane & 15, fq = lane >> 4;
    const int K = g.K, nt = K / BK;
    unsigned voffA[2], voffB[2];
#pragma unroll
    for (int i = 0; i < 2; ++i) { int R, C; stage_rc(tid * 16 + i * 8192, R, C); const int Rb = Epi::PERM ? ((R & ~31) + perm32(R & 31)) : R;
        voffA[i] = (unsigned)(R * K + C) * 2u; voffB[i] = (unsigned)(Rb * K + C) * 2u; }
    const size_t kstep = (size_t)(BK * 2);
    const size_t hstep = (size_t)HALF * K * 2;
    const size_t tstep = 2 * hstep;
    const unsigned ldsw = (unsigned)wid * 1024u;
    const int aoff = lds_byte(wr * 64 + fr, fq * 8), boff = lds_byte(wc * 32 + fr, fq * 8);
#define PG8_SA(b, h) (((b) * 2 + (h)) * HTB)
#define PG8_SB(b, h) ((4 + (b) * 2 + (h)) * HTB)
#define PG8_STAGE(bufoff, gbase, voff) do { _Pragma("unroll") for (int _i = 0; _i < 2; ++_i) \
        __builtin_amdgcn_global_load_lds((const unsigned*)((const char*)(gbase) + (voff)[_i]), (PG8_LAS unsigned*)(lds + (bufoff) + ldsw + _i * 8192), 16, 0, 0); } while (0)
#define PG8_LDA(dst, b, h) do { _Pragma("unroll") for (int m = 0; m < 4; ++m) _Pragma("unroll") for (int k = 0; k < 2; ++k) dst[m][k] = *(const PG8_LAS bf16x8*)(lds + PG8_SA(b, h) + aoff + m * 2048 + k * 1024); } while (0)
#define PG8_LDB(dst, b, h) do { _Pragma("unroll") for (int n = 0; n < 2; ++n) _Pragma("unroll") for (int k = 0; k < 2; ++k) dst[n][k] = *(const PG8_LAS bf16x8*)(lds + PG8_SB(b, h) + boff + n * 2048 + k * 1024); } while (0)
#define PG8_MMA(ai, bj, At, Bt) do { __builtin_amdgcn_s_setprio(1); _Pragma("unroll") for (int m = 0; m < 4; ++m) _Pragma("unroll") for (int n = 0; n < 2; ++n) _Pragma("unroll") for (int k = 0; k < 2; ++k) \
        acc[ai][bj][m][n] = __builtin_amdgcn_mfma_f32_16x16x32_bf16(Bt[n][k], At[m][k], acc[ai][bj][m][n], 0, 0, 0); __builtin_amdgcn_s_setprio(0); } while (0)
#define PG8_WAIT_V(n) asm volatile("s_waitcnt vmcnt(" #n ")" ::: "memory")
#define PG8_WAIT_L(n) asm volatile("s_waitcnt lgkmcnt(" #n ")" ::: "memory")
#define PG8_BAR __builtin_amdgcn_s_barrier()
#define PG8_SCHED __builtin_amdgcn_sched_barrier(0)
    Unit cur, nxt; int ui = 0;
    if (!S.next(0, cur)) return;
    f32x4 acc[2][2][4][2];
#pragma unroll
    for (int a = 0; a < 2; ++a)
#pragma unroll
        for (int b = 0; b < 2; ++b)
#pragma unroll
            for (int m = 0; m < 4; ++m)
#pragma unroll
                for (int n = 0; n < 2; ++n) acc[a][b][m][n] = (f32x4){0.f, 0.f, 0.f, 0.f};
    bf16x8 At[4][2], B0[2][2], B1[2][2];
    const char* cA = (const char*)g.A + (size_t)cur.pm * tstep; const char* cB = (const char*)g.Bt + (size_t)cur.pn * tstep;
    S.a_ready(cur);
    if constexpr (SP2) {
        PG8_STAGE(PG8_SB(0, 0), cB, voffB); PG8_STAGE(PG8_SB(0, 1), cB + hstep, voffB); PG8_STAGE(PG8_SA(0, 0), cA, voffA); PG8_STAGE(PG8_SA(0, 1), cA + hstep, voffA);
        if (wr == 1) PG8_BAR;
        PG8_WAIT_V(2); PG8_BAR;
        PG8_STAGE(PG8_SB(1, 0), cB + kstep, voffB); PG8_STAGE(PG8_SA(1, 0), cA + kstep, voffA); PG8_STAGE(PG8_SB(1, 1), cB + hstep + kstep, voffB);
        PG8_WAIT_V(6); PG8_BAR;
    } else {
        PG8_STAGE(PG8_SB(0, 0), cB, voffB); PG8_STAGE(PG8_SA(0, 0), cA, voffA); PG8_STAGE(PG8_SB(0, 1), cB + hstep, voffB); PG8_STAGE(PG8_SA(0, 1), cA + hstep, voffA);
        if (wr == 1) PG8_BAR;
        PG8_WAIT_V(4); PG8_BAR;
        PG8_STAGE(PG8_SB(1, 0), cB + kstep, voffB); PG8_STAGE(PG8_SA(1, 0), cA + kstep, voffA); PG8_STAGE(PG8_SB(1, 1), cB + hstep + kstep, voffB);
        PG8_WAIT_V(6); PG8_BAR;
    }
    for (;;) {
        const bool has_next = S.next(ui + 1, nxt);
        const char* nA = has_next ? (const char*)g.A + (size_t)nxt.pm * tstep : cA; const char* nB = has_next ? (const char*)g.Bt + (size_t)nxt.pn * tstep : cB;
        for (int t = 0; t < nt; t += 2) {
            const bool last = (t == nt - 2);
            const char* a1 = cA + (size_t)(t + 1) * kstep;
            const char* a2 = last ? nA : cA + (size_t)(t + 2) * kstep; const char* b2 = last ? nB : cB + (size_t)(t + 2) * kstep;
            const char* a3 = a2 + kstep; const char* b3 = b2 + kstep;
            if (last && has_next) S.a_ready(nxt);
            if constexpr (SP2) {
            PG8_LDB(B0, 0, 0); PG8_LDB(B1, 0, 1); PG8_SCHED; PG8_LDA(At, 0, 0); PG8_STAGE(PG8_SA(1, 1), a1 + hstep, voffA);
            PG8_WAIT_V(8); PG8_WAIT_L(0); PG8_BAR; PG8_MMA(0, 0, At, B0); PG8_MMA(0, 1, At, B1); PG8_BAR; PG8_SCHED;
            PG8_LDA(At, 0, 1); PG8_STAGE(PG8_SB(0, 0), b2, voffB); PG8_STAGE(PG8_SB(0, 1), b2 + hstep, voffB); PG8_STAGE(PG8_SA(0, 0), a2, voffA);
            PG8_WAIT_V(8); PG8_WAIT_L(0); PG8_BAR; PG8_MMA(1, 0, At, B0); PG8_MMA(1, 1, At, B1); PG8_BAR; PG8_SCHED;
            PG8_LDB(B0, 1, 0); PG8_LDB(B1, 1, 1); PG8_SCHED; PG8_LDA(At, 1, 0); PG8_STAGE(PG8_SA(0, 1), a2 + hstep, voffA);
            PG8_WAIT_V(8); PG8_WAIT_L(0); PG8_BAR; PG8_MMA(0, 0, At, B0); PG8_MMA(0, 1, At, B1); PG8_BAR; PG8_SCHED;
            PG8_LDA(At, 1, 1); PG8_STAGE(PG8_SB(1, 0), b3, voffB); PG8_STAGE(PG8_SB(1, 1), b3 + hstep, voffB); PG8_STAGE(PG8_SA(1, 0), a3, voffA);
            PG8_WAIT_V(8); PG8_WAIT_L(0); PG8_BAR; PG8_MMA(1, 0, At, B0); PG8_MMA(1, 1, At, B1); PG8_BAR; PG8_SCHED;
            } else {
            PG8_LDB(B0, 0, 0); PG8_SCHED; PG8_LDA(At, 0, 0); PG8_STAGE(PG8_SA(1, 1), a1 + hstep, voffA);
            PG8_WAIT_L(8); PG8_BAR; PG8_WAIT_L(0); PG8_MMA(0, 0, At, B0); PG8_BAR; PG8_SCHED;
            PG8_LDB(B1, 0, 1); PG8_STAGE(PG8_SB(0, 0), b2, voffB);
            PG8_BAR; PG8_WAIT_L(0); PG8_MMA(0, 1, At, B1); PG8_BAR;
            PG8_LDA(At, 0, 1); PG8_STAGE(PG8_SA(0, 0), a2, voffA);
            PG8_BAR; PG8_WAIT_L(0); PG8_MMA(1, 0, At, B0); PG8_BAR; PG8_SCHED;
            PG8_STAGE(PG8_SB(0, 1), b2 + hstep, voffB);
            PG8_WAIT_V(6); PG8_BAR; PG8_MMA(1, 1, At, B1); PG8_BAR;
            PG8_LDB(B0, 1, 0); PG8_SCHED; PG8_LDA(At, 1, 0); PG8_STAGE(PG8_SA(0, 1), a2 + hstep, voffA);
            PG8_WAIT_L(8); PG8_BAR; PG8_WAIT_L(0); PG8_MMA(0, 0, At, B0); PG8_BAR; PG8_SCHED;
            PG8_LDB(B1, 1, 1); PG8_STAGE(PG8_SB(1, 0), b3, voffB);
            PG8_BAR; PG8_WAIT_L(0); PG8_MMA(0, 1, At, B1); PG8_BAR;
            PG8_LDA(At, 1, 1); PG8_STAGE(PG8_SA(1, 0), a3, voffA);
            PG8_BAR; PG8_WAIT_L(0); PG8_MMA(1, 0, At, B0); PG8_BAR; PG8_SCHED;
            PG8_STAGE(PG8_SB(1, 1), b3 + hstep, voffB);
            PG8_WAIT_V(6); PG8_BAR; PG8_MMA(1, 1, At, B1); PG8_BAR;
            }
        }
        if constexpr (ALIGN_EPI) { if (wr == 0) PG8_BAR; }
        if constexpr (!Epi::AFTER_DRAIN) { E(acc, cur, wr, wc, fr, fq); S.done(cur); }
        if (!has_next) break;
#pragma unroll
        for (int a = 0; a < 2; ++a)
#pragma unroll
            for (int b = 0; b < 2; ++b)
#pragma unroll
                for (int m = 0; m < 4; ++m)
#pragma unroll
                    for (int n = 0; n < 2; ++n) acc[a][b][m][n] = (f32x4){0.f, 0.f, 0.f, 0.f};
        cur = nxt; cA = nA; cB = nB; ++ui;
        if constexpr (ALIGN_EPI) { if (wr == 1) PG8_BAR; }
    }
    PG8_WAIT_V(0);
    if constexpr (!ALIGN_EPI) { if (wr == 0) PG8_BAR; }
    PG8_BAR;
    if constexpr (Epi::AFTER_DRAIN) { E.fused(acc, cur, wr, wc, fr, fq, lds, wid, lane); S.done(cur); }
#undef PG8_SA
#undef PG8_SB
#undef PG8_STAGE
#undef PG8_LDA
#undef PG8_LDB
#undef PG8_MMA
#undef PG8_WAIT_V
#undef PG8_WAIT_L
#undef PG8_BAR
#undef PG8_SCHED
}
}

constexpr int NWAVES = 8, NTHR = NWAVES * 64;
constexpr int BATCH = 8, SEQ = 4096, D = 1024, FF = 2816, M = BATCH * SEQ;
constexpr int KCONF = 31;
constexpr float RMS_EPS = 1e-6f, LN_EPS = 1e-5f;
constexpr int NPHASE = 12;
constexpr size_t MiB = 1u << 20;
constexpr size_t WS_STATS = 1 * MiB;
constexpr size_t WS_WIN = 4 * MiB, WS_WOUT = 10 * MiB, WS_PW1 = 12 * MiB, WS_PW2 = 16 * MiB;
constexpr size_t WS_WGU0 = 18 * MiB, WS_WGU1 = 29 * MiB, WS_WDN0 = 40 * MiB, WS_WDN1 = 46 * MiB;
constexpr size_t WS_XB = 64 * MiB;
constexpr size_t WS_H = 128 * MiB;
constexpr size_t WS_BG = 256 * MiB, WS_CV = 320 * MiB, WS_Y = 384 * MiB;
constexpr size_t WS_GU = 256 * MiB;
constexpr size_t WS_END = 448 * MiB;
static_assert(WS_WDN1 + (size_t)D * FF * 2 <= WS_XB && WS_WGU0 + (size_t)2 * FF * D * 2 <= WS_WGU1 && WS_WDN0 + (size_t)D * FF * 2 <= WS_WDN1 && WS_GU + (size_t)M * FF * 2 <= WS_END, "d_ws map");
constexpr int RING_BYTES = 131072;
constexpr int LDS_BYTES = 147456;

#define GAS __attribute__((address_space(1)))
#define LAS __attribute__((address_space(3)))
typedef unsigned short bf16;
typedef unsigned v4u __attribute__((ext_vector_type(4)));
typedef unsigned v2u __attribute__((ext_vector_type(2)));
typedef float f32x4 __attribute__((ext_vector_type(4)));
typedef float f32x2 __attribute__((ext_vector_type(2)));
#define LDS_WAIT() asm volatile("s_waitcnt lgkmcnt(0)" ::: "memory")
__device__ __forceinline__ unsigned f2bf(float f) { unsigned u = __builtin_bit_cast(unsigned, f); return (u + 0x7fffu + ((u >> 16) & 1u)) >> 16; }
__device__ __forceinline__ unsigned pk2(float lo, float hi) { return f2bf(lo) | (f2bf(hi) << 16); }
__device__ __forceinline__ float bf_lo(unsigned u) { return __builtin_bit_cast(float, u << 16); }
__device__ __forceinline__ float bf_hi(unsigned u) { return __builtin_bit_cast(float, u & 0xffff0000u); }
__device__ __forceinline__ float wave_sum(float v) {
#pragma unroll
    for (int o = 1; o < 64; o <<= 1) v += __shfl_xor(v, o);
    return v;
}
__device__ __forceinline__ float sigm(float x) { return __builtin_amdgcn_rcpf(1.0f + __builtin_amdgcn_exp2f(-1.4426950408889634f * x)); }

__device__ __forceinline__ void p0_transpose_item(const float* W, int K, int N, const float* gain, bf16* WT, int kb, int n0, int drow0, LAS float* scr, int lane) {
    const int k0 = 64 * kb;
#pragma unroll 8
    for (int i = 0; i < 32; ++i) { const int kk = 2 * i + (lane >> 5); scr[kk * 33 + (lane & 31)] = W[(size_t)(k0 + kk) * N + n0 + (lane & 31)]; }
    LDS_WAIT(); asm volatile("" ::: "memory");
    const int c = lane & 7;
    float gk[8];
#pragma unroll
    for (int e = 0; e < 8; ++e) gk[e] = gain ? gain[k0 + 8 * c + e] : 1.0f;
#pragma unroll
    for (int j = 0; j < 4; ++j) { const int n = (lane >> 3) + 8 * j; const LAS float* s = scr + (8 * c) * 33 + n;
        v4u o; o.x = pk2(s[0 * 33] * gk[0], s[1 * 33] * gk[1]); o.y = pk2(s[2 * 33] * gk[2], s[3 * 33] * gk[3]); o.z = pk2(s[4 * 33] * gk[4], s[5 * 33] * gk[5]); o.w = pk2(s[6 * 33] * gk[6], s[7 * 33] * gk[7]);
        *(GAS v4u*)(WT + (size_t)(drow0 + n) * K + k0 + 8 * c) = o; }
    LDS_WAIT(); asm volatile("" ::: "memory");
}
__device__ __forceinline__ int inter128(int j, int h) { return 256 * (j >> 7) + 128 * h + (j & 127); }

struct Args { const float* in[19]; float* out; unsigned char* ws; int ph_lo, ph_hi; };

__global__ void __launch_bounds__(NTHR, 2) trunk_fwd(Args args) {
    extern __shared__ __attribute__((aligned(16))) unsigned char lds_raw[];
    LAS unsigned char* lds = (LAS unsigned char*)lds_raw;
    const int tid = threadIdx.x, lane = tid & 63, wave = __builtin_amdgcn_readfirstlane(tid >> 6);
    const int G = gridDim.x, bid = blockIdx.x;
    unsigned char* ws = args.ws;
    const float* x = args.in[0];
    const float *a_norm = args.in[1], *a_w_in = args.in[2], *a_conv = args.in[3], *a_w_out = args.in[4];
    const float *b_norm = args.in[5], *b_w_pw1 = args.in[6], *b_b_pw1 = args.in[7], *b_conv = args.in[8], *b_b_conv = args.in[9], *b_ln_g = args.in[10], *b_ln_b = args.in[11], *b_w_pw2 = args.in[12], *b_b_pw2 = args.in[13];
    const float *ffn_norm = args.in[14], *ffn_w_gate = args.in[15], *ffn_w_up = args.in[16], *ffn_w_down = args.in[17], *final_norm = args.in[18];
    float* out = args.out;
    float* STATS = (float*)(ws + WS_STATS);
    bf16 *Win_t = (bf16*)(ws + WS_WIN), *Wout_t = (bf16*)(ws + WS_WOUT), *Wpw1_t = (bf16*)(ws + WS_PW1), *Wpw2_t = (bf16*)(ws + WS_PW2);
    bf16 *XB = (bf16*)(ws + WS_XB), *BG = (bf16*)(ws + WS_BG), *CV = (bf16*)(ws + WS_CV), *Y = (bf16*)(ws + WS_Y), *GU = (bf16*)(ws + WS_GU);
    float* H = (float*)(ws + WS_H);
    const int lo = args.ph_lo, hi = args.ph_hi;
#define IN(k) (lo <= (k) && (k) < hi)
#if MK_PER_PHASE
#define SEAM(k) do { } while (0)
#else
#define SEAM(k) do { if (IN(k) && IN((k) + 1)) { __threadfence(); cg::this_grid().sync(); } } while (0)
#endif

    if (IN(0)) {
        LAS float* scr = (LAS float*)(lds + wave * 16384);
        const int gw = bid * NWAVES + wave, NGW = G * NWAVES;
        constexpr int I_IN = 16 * 96, I_SQ = 16 * 32, I_PW1 = 16 * 64, I_GU = 16 * 88, I_DN = 44 * 32;
        constexpr int NITEMS = I_IN + 2 * I_SQ + I_PW1 + 4 * I_GU + 2 * I_DN;
        for (int it = gw; it < NITEMS; it += NGW) {
            int r = it;
            if (r < I_IN) { const int kb = r / 96, n0 = 32 * (r % 96); const int dr = n0 < 1024 ? 2048 + n0 : (n0 < 2048 ? inter128(n0 - 1024, 0) : inter128(n0 - 2048, 1));
                p0_transpose_item(a_w_in, D, 3 * D, a_norm, Win_t, kb, n0, dr, scr, lane); continue; } r -= I_IN;
            if (r < I_SQ) { const int kb = r / 32, n0 = 32 * (r % 32); p0_transpose_item(a_w_out, D, D, nullptr, Wout_t, kb, n0, n0, scr, lane); continue; } r -= I_SQ;
            if (r < I_SQ) { const int kb = r / 32, n0 = 32 * (r % 32); p0_transpose_item(b_w_pw2, D, D, nullptr, Wpw2_t, kb, n0, n0, scr, lane); continue; } r -= I_SQ;
            if (r < I_PW1) { const int kb = r / 64, n0 = 32 * (r % 64); const int dr = n0 < 1024 ? inter128(n0, 0) : inter128(n0 - 1024, 1);
                p0_transpose_item(b_w_pw1, D, 2 * D, b_norm, Wpw1_t, kb, n0, dr, scr, lane); continue; } r -= I_PW1;
            if (r < 4 * I_GU) { const int q = r / I_GU, rr = r % I_GU, layer = q >> 1, hsel = q & 1; const int kb = rr / 88, n0 = 32 * (rr % 88);
                const float* W = (hsel ? ffn_w_up : ffn_w_gate) + (size_t)layer * D * FF; bf16* WT = (bf16*)(ws + (layer ? WS_WGU1 : WS_WGU0));
                p0_transpose_item(W, D, FF, ffn_norm + layer * D, WT, kb, n0, inter128(n0, hsel), scr, lane); continue; } r -= 4 * I_GU;
            { const int layer = r / I_DN, rr = r % I_DN; const int kb = rr / 32, n0 = 32 * (rr % 32);
                p0_transpose_item(ffn_w_down + (size_t)layer * FF * D, FF, D, nullptr, (bf16*)(ws + (layer ? WS_WDN1 : WS_WDN0)), kb, n0, n0, scr, lane); }
        }
        for (int m = gw; m < M; m += NGW) {
            const GAS f32x4* xr = (const GAS f32x4*)(x + (size_t)m * D) + lane; f32x4 v[4]; float s = 0.f;
#pragma unroll
            for (int j = 0; j < 4; ++j) { v[j] = xr[64 * j]; s += (v[j].x * v[j].x + v[j].y * v[j].y) + (v[j].z * v[j].z + v[j].w * v[j].w); }
            s = wave_sum(s);
            GAS v2u* o8 = (GAS v2u*)(XB + (size_t)m * D) + lane;
#pragma unroll
            for (int j = 0; j < 4; ++j) { v2u o; o.x = pk2(v[j].x, v[j].y); o.y = pk2(v[j].z, v[j].w); o8[64 * j] = o; }
            if (lane < pg8::NSTAT) STATS[(size_t)m * pg8::NSTAT + lane] = lane == 0 ? s : 0.f;
        }
    }
    SEAM(0);
    if (IN(1)) {
        pg8::Gemm g{XB, Win_t, M, 3 * D, D}; pg8::StaticOrder S; S.init(M, 3 * D, G, bid);
        pg8::EpiPair<2> E{CV, D, BG, STATS, nullptr};
        pg8::gemm_phase<pg8::EpiPair<2>, pg8::StaticOrder, true, true>(lds, g, S, E);
    }
    SEAM(1);
    if (IN(2)) {
        const int cg8 = tid & 127, sub = tid >> 7;
        float w0[8], w1[8], w2[8];
#pragma unroll
        for (int e = 0; e < 8; ++e) { w0[e] = a_conv[8 * cg8 + e]; w1[e] = a_conv[D + 8 * cg8 + e]; w2[e] = a_conv[2 * D + 8 * cg8 + e]; }
        constexpr int CH = 32;
        for (int chunk = bid * 4 + sub; chunk < M / CH; chunk += G * 4) {
            const int t0 = chunk * CH; const bool first = (t0 & (SEQ - 1)) == 0;
            const GAS v4u* cvp = (const GAS v4u*)(CV + (size_t)t0 * D + 8 * cg8); const GAS v4u* bgp = (const GAS v4u*)(BG + (size_t)t0 * D + 8 * cg8); GAS v4u* yp = (GAS v4u*)(Y + (size_t)t0 * D + 8 * cg8);
            float p2[8], p1[8];
            { v4u a = (v4u){0u, 0u, 0u, 0u}, b = a; if (!first) { a = cvp[-2 * (D / 8)]; b = cvp[-1 * (D / 8)]; }
#pragma unroll
              for (int e = 0; e < 4; ++e) { p2[2 * e] = bf_lo(a[e]); p2[2 * e + 1] = bf_hi(a[e]); p1[2 * e] = bf_lo(b[e]); p1[2 * e + 1] = bf_hi(b[e]); } }
#pragma unroll 8
            for (int t = 0; t < CH; ++t) {
                const v4u c = cvp[t * (D / 8)], bgv = bgp[t * (D / 8)]; float cur[8], o[8];
#pragma unroll
                for (int e = 0; e < 4; ++e) { cur[2 * e] = bf_lo(c[e]); cur[2 * e + 1] = bf_hi(c[e]); }
#pragma unroll
                for (int e = 0; e < 4; ++e) { o[2 * e] = bf_lo(bgv[e]) * (w0[2 * e] * p2[2 * e] + w1[2 * e] * p1[2 * e] + w2[2 * e] * cur[2 * e]);
                                              o[2 * e + 1] = bf_hi(bgv[e]) * (w0[2 * e + 1] * p2[2 * e + 1] + w1[2 * e + 1] * p1[2 * e + 1] + w2[2 * e + 1] * cur[2 * e + 1]); }
                v4u ov; ov.x = pk2(o[0], o[1]); ov.y = pk2(o[2], o[3]); ov.z = pk2(o[4], o[5]); ov.w = pk2(o[6], o[7]);
                yp[t * (D / 8)] = ov;
#pragma unroll
                for (int e = 0; e < 8; ++e) { p2[e] = p1[e]; p1[e] = cur[e]; }
            }
        }
    }
    SEAM(2);
    if (IN(3)) {
        pg8::Gemm g{Y, Wout_t, M, D, D}; pg8::StaticOrder S; S.init(M, D, G, bid);
        pg8::EpiRes E{x, H, XB, STATS, nullptr};
        pg8::gemm_phase<pg8::EpiRes, pg8::StaticOrder, true, true>(lds, g, S, E);
    }
    SEAM(3);
    if (IN(4)) {
        pg8::Gemm g{XB, (const bf16*)(ws + WS_WGU0), M, 2 * FF, D}; pg8::StaticOrder S; S.init(M, 2 * FF, G, bid);
        pg8::EpiPair<0> E{GU, FF, nullptr, STATS, nullptr};
        pg8::gemm_phase<pg8::EpiPair<0>, pg8::StaticOrder, true, true>(lds, g, S, E);
    }
    SEAM(4);
    if (IN(5)) {
        pg8::Gemm g{GU, (const bf16*)(ws + WS_WDN0), M, D, FF}; pg8::StaticOrder S; S.init(M, D, G, bid);
        pg8::EpiRes E{H, H, XB, STATS, nullptr};
        pg8::gemm_phase<pg8::EpiRes, pg8::StaticOrder, true, true>(lds, g, S, E);
    }
    SEAM(5);
    if (IN(6)) {
        pg8::Gemm g{XB, Wpw1_t, M, 2 * D, D}; pg8::StaticOrder S; S.init(M, 2 * D, G, bid);
        pg8::EpiPair<1> E{BG, D, nullptr, STATS, b_b_pw1};
        pg8::gemm_phase<pg8::EpiPair<1>, pg8::StaticOrder, true, true>(lds, g, S, E);
    }
    SEAM(6);
    if (IN(7)) {
        const int c0 = 2 * tid;
        f32x2 w[KCONF];
#pragma unroll
        for (int k = 0; k < KCONF; ++k) w[k] = *(const f32x2*)(b_conv + k * D + c0);
        const f32x2 cb = *(const f32x2*)(b_b_conv + c0);
        LAS float* T = (LAS float*)lds;
        for (int tile = bid; tile < M / 32; tile += G) {
            const int t0 = tile * 32; const bool first = (t0 & (SEQ - 1)) == 0;
            f32x2 acc[32];
#pragma unroll
            for (int t = 0; t < 32; ++t) acc[t] = cb;
            const GAS unsigned* src = (const GAS unsigned*)(BG + ((long)t0 - 30) * D + c0);
#pragma unroll
            for (int s = 0; s < 62; ++s) {
                unsigned u = 0u; if (!(s < 30 && first)) u = src[(long)s * (D / 2)];
                const f32x2 xv = (f32x2){bf_lo(u), bf_hi(u)};
#pragma unroll
                for (int t = (s > 30 ? s - 30 : 0); t <= (s < 31 ? s : 31); ++t) acc[t] += w[s - t] * xv;
            }
#pragma unroll
            for (int t = 0; t < 32; ++t) *(LAS f32x2*)(T + t * D + c0) = acc[t];
            __syncthreads();
#pragma unroll
            for (int q = 0; q < 4; ++q) { const int t = wave * 4 + q; f32x4 v[4]; float s = 0.f;
#pragma unroll
                for (int j = 0; j < 4; ++j) { v[j] = *(const LAS f32x4*)(T + t * D + 4 * lane + 256 * j); s += (v[j].x + v[j].y) + (v[j].z + v[j].w); }
                const float mean = wave_sum(s) * (1.f / D); float s2 = 0.f;
#pragma unroll
                for (int j = 0; j < 4; ++j) { v[j] = v[j] - mean; s2 += (v[j].x * v[j].x + v[j].y * v[j].y) + (v[j].z * v[j].z + v[j].w * v[j].w); }
                const float rstd = 1.f / sqrtf(wave_sum(s2) * (1.f / D) + LN_EPS);
                GAS v2u* o8 = (GAS v2u*)(CV + (size_t)(t0 + t) * D) + lane;
#pragma unroll
                for (int j = 0; j < 4; ++j) { const f32x4 gg = *(const f32x4*)(b_ln_g + 4 * lane + 256 * j), bb = *(const f32x4*)(b_ln_b + 4 * lane + 256 * j);
                    f32x4 y = v[j] * rstd * gg + bb; y.x *= sigm(y.x); y.y *= sigm(y.y); y.z *= sigm(y.z); y.w *= sigm(y.w);
                    v2u o; o.x = pk2(y.x, y.y); o.y = pk2(y.z, y.w); o8[64 * j] = o; } }
            __syncthreads();
        }
    }
    SEAM(7);
    if (IN(8)) {
        pg8::Gemm g{CV, Wpw2_t, M, D, D}; pg8::StaticOrder S; S.init(M, D, G, bid);
        pg8::EpiRes E{H, H, XB, STATS, b_b_pw2};
        pg8::gemm_phase<pg8::EpiRes, pg8::StaticOrder, true, true>(lds, g, S, E);
    }
    SEAM(8);
    if (IN(9)) {
        pg8::Gemm g{XB, (const bf16*)(ws + WS_WGU1), M, 2 * FF, D}; pg8::StaticOrder S; S.init(M, 2 * FF, G, bid);
        pg8::EpiPair<0> E{GU, FF, nullptr, STATS, nullptr};
        pg8::gemm_phase<pg8::EpiPair<0>, pg8::StaticOrder, true, true>(lds, g, S, E);
    }
    SEAM(9);
    if (IN(10)) {
        pg8::Gemm g{GU, (const bf16*)(ws + WS_WDN1), M, D, FF}; pg8::StaticOrder S; S.init(M, D, G, bid);
        pg8::EpiRes E{H, out, nullptr, nullptr, nullptr};
        pg8::gemm_phase<pg8::EpiRes, pg8::StaticOrder, true, true>(lds, g, S, E);
    }
    SEAM(10);
    if (IN(11)) {
        const int gw = bid * NWAVES + wave, NGW = G * NWAVES;
        f32x4 gn[4];
#pragma unroll
        for (int j = 0; j < 4; ++j) gn[j] = *(const f32x4*)(final_norm + 4 * lane + 256 * j);
        for (int m = gw; m < M; m += NGW) {
            GAS f32x4* xr = (GAS f32x4*)(out + (size_t)m * D) + lane; f32x4 v[4]; float s = 0.f;
#pragma unroll
            for (int j = 0; j < 4; ++j) { v[j] = xr[64 * j]; s += (v[j].x * v[j].x + v[j].y * v[j].y) + (v[j].z * v[j].z + v[j].w * v[j].w); }
            const float r = 1.f / sqrtf(wave_sum(s) * (1.f / D) + RMS_EPS);
#pragma unroll
            for (int j = 0; j < 4; ++j) xr[64 * j] = v[j] * r * gn[j];
        }
    }
#undef IN
#undef SEAM
}

extern "C" void kernel_launch(void* const* d_in, const int* in_sizes, int n_in, void* d_out, int out_size, void* d_ws, size_t ws_size, hipStream_t stream) {
    static int grid = 0;
    if (grid == 0) {
        if (n_in != 19 || in_sizes[0] != M * D || out_size != M * D || ws_size < WS_END) { fprintf(stderr, "kernel_launch: shape/workspace mismatch: n_in %d in0 %d out %d ws %zu (need %zu); nothing launched\n", n_in, n_in > 0 ? in_sizes[0] : -1, out_size, ws_size, (size_t)WS_END); grid = -1; return; }
        int dev = 0, cus = 0, per_cu = 0;
        if (hipGetDevice(&dev) != hipSuccess || hipDeviceGetAttribute(&cus, hipDeviceAttributeMultiprocessorCount, dev) != hipSuccess) { fprintf(stderr, "kernel_launch: device query failed\n"); grid = -1; return; }
        if (hipFuncSetAttribute((const void*)trunk_fwd, hipFuncAttributeMaxDynamicSharedMemorySize, LDS_BYTES) != hipSuccess) { fprintf(stderr, "kernel_launch: hipFuncSetAttribute failed\n"); grid = -1; return; }
        if (hipOccupancyMaxActiveBlocksPerMultiprocessor(&per_cu, (const void*)trunk_fwd, NTHR, LDS_BYTES) != hipSuccess || per_cu < 1) { fprintf(stderr, "kernel_launch: occupancy query says %d blocks/CU; using 1\n", per_cu); per_cu = 1; }
        (void)hipGetLastError();
        grid = cus * per_cu;
    }
    if (grid < 0) return;
    Args a{};
    for (int i = 0; i < 19; ++i) a.in[i] = (const float*)d_in[i];
    a.out = (float*)d_out; a.ws = (unsigned char*)d_ws;
#if MK_PER_PHASE
    for (int p = 0; p < NPHASE; ++p) { a.ph_lo = p; a.ph_hi = p + 1; hipLaunchKernelGGL(trunk_fwd, dim3(grid), dim3(NTHR), LDS_BYTES, stream, a); }
#else
    a.ph_lo = 0; a.ph_hi = NPHASE;
    void* kargs[] = {&a};
    hipError_t e = hipLaunchCooperativeKernel((const void*)trunk_fwd, dim3(grid), dim3(NTHR), kargs, LDS_BYTES, stream);
    if (e != hipSuccess) fprintf(stderr, "kernel_launch: cooperative launch failed: %s (grid %d)\n", hipGetErrorString(e), grid);
#endif
}
```

```cpp
#include <hip/hip_runtime.h>
#include <hip/hip_cooperative_groups.h>
#include <cstdio>
#include <cstdint>
namespace cg = cooperative_groups;
#ifndef MK_PROBE_PHASE
#define MK_PROBE_PHASE -1
#endif
#ifndef MK_PER_PHASE
#define MK_PER_PHASE 0
#endif
namespace pg8 {
#define PG8_LAS __attribute__((address_space(3)))
typedef unsigned short bf16_t;
typedef short bf16x8 __attribute__((ext_vector_type(8)));
typedef float f32x4 __attribute__((ext_vector_type(4)));
typedef unsigned u32x4 __attribute__((ext_vector_type(4)));
constexpr int BM = 256, BK = 64, HALF = 128, HTB = HALF * BK * 2  , STAGE_BYTES = 8 * HTB, NXCD = 8, WGM = 4;

__host__ __device__ __forceinline__ int lds_byte(int r, int c) { const int st = (r >> 4) * 2 + (c >> 5), rr = r & 15, cc = c & 31, ob = rr * 64 + cc * 2; return st * 1024 + (ob ^ (((ob >> 9) & 1) << 5)); }
__host__ __device__ __forceinline__ void stage_rc(int b, int& R, int& C) { const int st = b / 1024, sb = b % 1024, swz = sb ^ (((sb >> 9) & 1) << 5); R = (st >> 1) * 16 + swz / 64; C = (st & 1) * 32 + (swz % 64) / 2; }
__host__ __device__ __forceinline__ int perm32(int rho) { const int n = rho >> 4, i = rho & 15; return 8 * (i >> 2) + 4 * n + (i & 3); }

struct Unit { int pm, pn; };
struct Gemm { const bf16_t* A; const bf16_t* Bt; int M, N, K; };

struct StaticOrder {
    int nM, nN, nwg, G, c;
    __host__ __device__ void init(int M, int N, int G_, int c_) { nM = M / BM; nN = N / BM; nwg = nM * nN; G = G_; c = c_; }
    __host__ __device__ bool next(int i, Unit& u) const {
        const long L = (long)i * G + c; if (L >= nwg) return false;
        int wgid = (int)L; { const int q = nwg / NXCD, r = nwg % NXCD, xcd = wgid % NXCD, off = wgid / NXCD; wgid = (xcd < r ? xcd * (q + 1) : r * (q + 1) + (xcd - r) * q) + off; }
        const int nig = WGM * nN, gid = wgid / nig, fm = gid * WGM, gsz = (nM - fm) < WGM ? (nM - fm) : WGM;
        u.pm = fm + ((wgid % nig) % gsz); u.pn = (wgid % nig) / gsz; return true;
    }
    __device__ __forceinline__ void a_ready(const Unit&) const {}
    __device__ __forceinline__ void done(const Unit&) const {}
};

__device__ __forceinline__ unsigned cvt_pk_bf16(float lo, float hi) { unsigned r; asm volatile("v_cvt_pk_bf16_f32 %0, %1, %2" : "=v"(r) : "v"(lo), "v"(hi)); return r; }
typedef float f32x2 __attribute__((ext_vector_type(2)));
__device__ __forceinline__ float sigmoid_f(float x) { return __builtin_amdgcn_rcpf(1.0f + __builtin_amdgcn_exp2f(-1.4426950408889634f * x)); }
constexpr int NSTAT = 4;
__device__ __forceinline__ void load_rscale(const float* stats, int row0, int fq, float (&rs)[2][4]) {
#pragma unroll
    for (int ai = 0; ai < 2; ++ai)
#pragma unroll
        for (int m = 0; m < 4; ++m) {
            const f32x4 p = *(const f32x4*)(stats + (size_t)(row0 + ai * HALF + m * 16) * NSTAT + fq * 4);
            float s = (p[0] + p[1]) + (p[2] + p[3]); s += __shfl_xor(s, 16); s += __shfl_xor(s, 32);
            rs[ai][m] = 1.0f / sqrtf(s * (1.0f / 1024.0f) + 1e-6f);
        }
}
__device__ __forceinline__ u32x4 pack8(const f32x4 v0, const f32x4 v1) { u32x4 w; w.x = cvt_pk_bf16(v0[0], v0[1]); w.y = cvt_pk_bf16(v0[2], v0[3]); w.z = cvt_pk_bf16(v1[0], v1[1]); w.w = cvt_pk_bf16(v1[2], v1[3]); return w; }
template <int MODE> struct EpiPair {
    static constexpr bool PERM = true, AFTER_DRAIN = false;
    bf16_t* O; int ldc; bf16_t* O2; const PG8_LAS float* rsl; const float* bias;
    __device__ __forceinline__ void operator()(const f32x4 (&acc)[2][2][4][2], const Unit& u, int ui, int wr, int wc, int fr, int fq) const {
        const int row0 = u.pm * BM + wr * 64 + fr, cw = wc * 32 + 8 * fq;
        float rs[2][4];
#pragma unroll
        for (int ai = 0; ai < 2; ++ai)
#pragma unroll
            for (int m = 0; m < 4; ++m) rs[ai][m] = rsl[ui * BM + ai * HALF + wr * 64 + m * 16 + fr];
        if (MODE == 2 && u.pn >= 8) {
#pragma unroll
            for (int ai = 0; ai < 2; ++ai)
#pragma unroll
                for (int m = 0; m < 4; ++m) { const float r = rs[ai][m]; bf16_t* rowp = O2 + (size_t)(row0 + ai * HALF + m * 16) * 1024 + (u.pn - 8) * BM + cw;
#pragma unroll
                    for (int bj = 0; bj < 2; ++bj) __builtin_nontemporal_store(pack8(acc[ai][bj][m][0] * r, acc[ai][bj][m][1] * r), (u32x4*)(rowp + bj * HALF)); }
            return;
        }
        f32x4 bp[2], bq[2];
#pragma unroll
        for (int n = 0; n < 2; ++n) { bp[n] = (f32x4){0.f, 0.f, 0.f, 0.f}; bq[n] = bp[n]; if (MODE == 1) { bp[n] = *(const f32x4*)(bias + u.pn * HALF + cw + 4 * n); bq[n] = *(const f32x4*)(bias + 1024 + u.pn * HALF + cw + 4 * n); } }
#pragma unroll
        for (int ai = 0; ai < 2; ++ai)
#pragma unroll
            for (int m = 0; m < 4; ++m) { const float r = rs[ai][m], r2 = r * r, rc = -1.4426950408889634f * r; bf16_t* rowp = O + (size_t)(row0 + ai * HALF + m * 16) * ldc + u.pn * HALF + cw;
                f32x4 o[2];
#pragma unroll
                for (int n = 0; n < 2; ++n) { const f32x4 ap = acc[ai][0][m][n], aq = acc[ai][1][m][n];
                    if (MODE == 0) { const f32x4 t = ap * rc; f32x4 d; d[0] = __builtin_amdgcn_exp2f(t[0]); d[1] = __builtin_amdgcn_exp2f(t[1]); d[2] = __builtin_amdgcn_exp2f(t[2]); d[3] = __builtin_amdgcn_exp2f(t[3]);
                        d = d + 1.0f; f32x4 s; s[0] = __builtin_amdgcn_rcpf(d[0]); s[1] = __builtin_amdgcn_rcpf(d[1]); s[2] = __builtin_amdgcn_rcpf(d[2]); s[3] = __builtin_amdgcn_rcpf(d[3]);
                        o[n] = (ap * aq) * (s * r2); }
                    else if (MODE == 1) { const f32x4 p = ap * r + bp[n], q = aq * r + bq[n], t = q * (-1.4426950408889634f); f32x4 d; d[0] = __builtin_amdgcn_exp2f(t[0]); d[1] = __builtin_amdgcn_exp2f(t[1]); d[2] = __builtin_amdgcn_exp2f(t[2]); d[3] = __builtin_amdgcn_exp2f(t[3]);
                        d = d + 1.0f; f32x4 s; s[0] = __builtin_amdgcn_rcpf(d[0]); s[1] = __builtin_amdgcn_rcpf(d[1]); s[2] = __builtin_amdgcn_rcpf(d[2]); s[3] = __builtin_amdgcn_rcpf(d[3]);
                        o[n] = p * s; }
                    else o[n] = (ap * aq) * r2; }
                __builtin_nontemporal_store(pack8(o[0], o[1]), (u32x4*)rowp); }
    }
};
struct EpiRes {
    static constexpr bool PERM = true, AFTER_DRAIN = false;
    bf16_t* xb; float* stats; const float* bias; PG8_LAS float* xl;
    __device__ __forceinline__ void operator()(const f32x4 (&acc)[2][2][4][2], const Unit& u, int ui, int wr, int wc, int fr, int fq) const {
        const int row0 = u.pm * BM + wr * 64 + fr, col0 = u.pn * BM + wc * 32 + 8 * fq;
        u32x4 b[2][2][2];
#define RES_LOAD(g) do { _Pragma("unroll") for (int mm = 0; mm < 2; ++mm) _Pragma("unroll") for (int bj = 0; bj < 2; ++bj) \
            b[(g) & 1][mm][bj] = *(const u32x4*)(xb + (size_t)(row0 + ((g) >> 1) * HALF + (2 * ((g) & 1) + mm) * 16) * 1024 + col0 + bj * HALF); } while (0)
        RES_LOAD(0); RES_LOAD(1);
        asm volatile("" ::: "memory");
#pragma unroll
        for (int g = 0; g < 4; ++g) {
#pragma unroll
            for (int mm = 0; mm < 2; ++mm) { const int ai = g >> 1, m = 2 * (g & 1) + mm; const int row = row0 + ai * HALF + m * 16; bf16_t* p = xb + (size_t)row * 1024 + col0; float ss = 0.f;
#pragma unroll
                for (int bj = 0; bj < 2; ++bj) { const u32x4 bb = b[g & 1][mm][bj];
                    const f32x4 b0 = (f32x4){__builtin_bit_cast(float, bb.x << 16), __builtin_bit_cast(float, bb.x & 0xffff0000u), __builtin_bit_cast(float, bb.y << 16), __builtin_bit_cast(float, bb.y & 0xffff0000u)};
                    const f32x4 b1 = (f32x4){__builtin_bit_cast(float, bb.z << 16), __builtin_bit_cast(float, bb.z & 0xffff0000u), __builtin_bit_cast(float, bb.w << 16), __builtin_bit_cast(float, bb.w & 0xffff0000u)};
                    f32x4 v0 = b0 + acc[ai][bj][m][0], v1 = b1 + acc[ai][bj][m][1];
                    if (bias) { v0 += *(const f32x4*)(bias + col0 + bj * HALF); v1 += *(const f32x4*)(bias + col0 + bj * HALF + 4); }
                    ss += (v0[0] * v0[0] + v0[1] * v0[1]) + (v0[2] * v0[2] + v0[3] * v0[3]) + (v1[0] * v1[0] + v1[1] * v1[1]) + (v1[2] * v1[2] + v1[3] * v1[3]);
                    *(u32x4*)(p + bj * HALF) = pack8(v0, v1); }
                ss += __shfl_xor(ss, 16); ss += __shfl_xor(ss, 32); if (fq == 0) xl[wc * BM + ai * HALF + wr * 64 + m * 16 + fr] = ss; }
            asm volatile("" ::: "memory");
            if (g + 2 < 4) { RES_LOAD(g + 2); asm volatile("" ::: "memory"); }
        }
#undef RES_LOAD
        asm volatile("s_waitcnt lgkmcnt(0)" ::: "memory"); __builtin_amdgcn_s_barrier(); asm volatile("" ::: "memory");
        if (threadIdx.x < 256) { const int r = threadIdx.x; stats[(size_t)(u.pm * BM + r) * NSTAT + u.pn] = (xl[r] + xl[BM + r]) + (xl[2 * BM + r] + xl[3 * BM + r]); }
    }
};
template <class Epi, class Sched, bool ALIGN_EPI = false, bool SP2 = false>
__device__ __forceinline__ void gemm_phase(PG8_LAS unsigned char* lds, const Gemm g, const Sched& S, const Epi& E) {
    const int tid = threadIdx.x, wid = __builtin_amdgcn_readfirstlane(tid >> 6), lane = tid & 63, wr = wid >> 2, wc = wid & 3, fr = lane & 15, fq = lane >> 4;
    const int K = g.K, nt = K / BK;
    unsigned voffA[2], voffB[2];
#pragma unroll
    for (int i = 0; i < 2; ++i) { int R, C; stage_rc(tid * 16 + i * 8192, R, C); const int Rb = Epi::PERM ? ((R & ~31) + perm32(R & 31)) : R;
        voffA[i] = (unsigned)(R * K + C) * 2u; voffB[i] = (unsigned)(Rb * K + C) * 2u; }
    const size_t kstep = (size_t)(BK * 2);
    const size_t hstep = (size_t)HALF * K * 2;
    const size_t tstep = 2 * hstep;
    const unsigned ldsw = (unsigned)wid * 1024u;
    const int aoff = lds_byte(wr * 64 + fr, fq * 8), boff = lds_byte(wc * 32 + fr, fq * 8);
#define PG8_SA(b, h) (((b) * 2 + (h)) * HTB)
#define PG8_SB(b, h) ((4 + (b) * 2 + (h)) * HTB)
#define PG8_STAGE(bufoff, gbase, voff) do { _Pragma("unroll") for (int _i = 0; _i < 2; ++_i) \
        __builtin_amdgcn_global_load_lds((const unsigned*)((const char*)(gbase) + (voff)[_i]), (PG8_LAS unsigned*)(lds + (bufoff) + ldsw + _i * 8192), 16, 0, 0); } while (0)
#define PG8_LDA(dst, b, h) do { _Pragma("unroll") for (int m = 0; m < 4; ++m) _Pragma("unroll") for (int k = 0; k < 2; ++k) dst[m][k] = *(const PG8_LAS bf16x8*)(lds + PG8_SA(b, h) + aoff + m * 2048 + k * 1024); } while (0)
#define PG8_LDB(dst, b, h) do { _Pragma("unroll") for (int n = 0; n < 2; ++n) _Pragma("unroll") for (int k = 0; k < 2; ++k) dst[n][k] = *(const PG8_LAS bf16x8*)(lds + PG8_SB(b, h) + boff + n * 2048 + k * 1024); } while (0)
#define PG8_MMA(ai, bj, At, Bt) do { __builtin_amdgcn_s_setprio(1); _Pragma("unroll") for (int m = 0; m < 4; ++m) _Pragma("unroll") for (int n = 0; n < 2; ++n) _Pragma("unroll") for (int k = 0; k < 2; ++k) \
        acc[ai][bj][m][n] = __builtin_amdgcn_mfma_f32_16x16x32_bf16(Bt[n][k], At[m][k], acc[ai][bj][m][n], 0, 0, 0); __builtin_amdgcn_s_setprio(0); } while (0)
#define PG8_WAIT_V(n) asm volatile("s_waitcnt vmcnt(" #n ")" ::: "memory")
#define PG8_WAIT_L(n) asm volatile("s_waitcnt lgkmcnt(" #n ")" ::: "memory")
#define PG8_BAR __builtin_amdgcn_s_barrier()
#define PG8_SCHED __builtin_amdgcn_sched_barrier(0)
    Unit cur, nxt; int ui = 0;
    if (!S.next(0, cur)) return;
    f32x4 acc[2][2][4][2];
#pragma unroll
    for (int a = 0; a < 2; ++a)
#pragma unroll
        for (int b = 0; b < 2; ++b)
#pragma unroll
            for (int m = 0; m < 4; ++m)
#pragma unroll
                for (int n = 0; n < 2; ++n) acc[a][b][m][n] = (f32x4){0.f, 0.f, 0.f, 0.f};
    bf16x8 At[4][2], B0[2][2], B1[2][2];
    const char* cA = (const char*)g.A + (size_t)cur.pm * tstep; const char* cB = (const char*)g.Bt + (size_t)cur.pn * tstep;
    S.a_ready(cur);
    if constexpr (SP2) {
        PG8_STAGE(PG8_SB(0, 0), cB, voffB); PG8_STAGE(PG8_SB(0, 1), cB + hstep, voffB); PG8_STAGE(PG8_SA(0, 0), cA, voffA); PG8_STAGE(PG8_SA(0, 1), cA + hstep, voffA);
        if (wr == 1) PG8_BAR;
        PG8_WAIT_V(2); PG8_BAR;
        PG8_STAGE(PG8_SB(1, 0), cB + kstep, voffB); PG8_STAGE(PG8_SA(1, 0), cA + kstep, voffA); PG8_STAGE(PG8_SB(1, 1), cB + hstep + kstep, voffB);
        PG8_WAIT_V(6); PG8_BAR;
    } else {
        PG8_STAGE(PG8_SB(0, 0), cB, voffB); PG8_STAGE(PG8_SA(0, 0), cA, voffA); PG8_STAGE(PG8_SB(0, 1), cB + hstep, voffB); PG8_STAGE(PG8_SA(0, 1), cA + hstep, voffA);
        if (wr == 1) PG8_BAR;
        PG8_WAIT_V(4); PG8_BAR;
        PG8_STAGE(PG8_SB(1, 0), cB + kstep, voffB); PG8_STAGE(PG8_SA(1, 0), cA + kstep, voffA); PG8_STAGE(PG8_SB(1, 1), cB + hstep + kstep, voffB);
        PG8_WAIT_V(6); PG8_BAR;
    }
    for (;;) {
        const bool has_next = S.next(ui + 1, nxt);
        const char* nA = has_next ? (const char*)g.A + (size_t)nxt.pm * tstep : cA; const char* nB = has_next ? (const char*)g.Bt + (size_t)nxt.pn * tstep : cB;
        for (int t = 0; t < nt; t += 2) {
            const bool last = (t == nt - 2);
            const char* a1 = cA + (size_t)(t + 1) * kstep;
            const char* a2 = last ? nA : cA + (size_t)(t + 2) * kstep; const char* b2 = last ? nB : cB + (size_t)(t + 2) * kstep;
            const char* a3 = a2 + kstep; const char* b3 = b2 + kstep;
            if (last && has_next) S.a_ready(nxt);
            if constexpr (SP2) {
            PG8_LDB(B0, 0, 0); PG8_LDB(B1, 0, 1); PG8_SCHED; PG8_LDA(At, 0, 0); PG8_STAGE(PG8_SA(1, 1), a1 + hstep, voffA);
            PG8_WAIT_V(8); PG8_WAIT_L(0); PG8_BAR; PG8_MMA(0, 0, At, B0); PG8_MMA(0, 1, At, B1); PG8_BAR; PG8_SCHED;
            PG8_LDA(At, 0, 1); PG8_STAGE(PG8_SB(0, 0), b2, voffB); PG8_STAGE(PG8_SB(0, 1), b2 + hstep, voffB); PG8_STAGE(PG8_SA(0, 0), a2, voffA);
            PG8_WAIT_V(8); PG8_WAIT_L(0); PG8_BAR; PG8_MMA(1, 0, At, B0); PG8_MMA(1, 1, At, B1); PG8_BAR; PG8_SCHED;
            PG8_LDB(B0, 1, 0); PG8_LDB(B1, 1, 1); PG8_SCHED; PG8_LDA(At, 1, 0); PG8_STAGE(PG8_SA(0, 1), a2 + hstep, voffA);
            PG8_WAIT_V(8); PG8_WAIT_L(0); PG8_BAR; PG8_MMA(0, 0, At, B0); PG8_MMA(0, 1, At, B1); PG8_BAR; PG8_SCHED;
            PG8_LDA(At, 1, 1); PG8_STAGE(PG8_SB(1, 0), b3, voffB); PG8_STAGE(PG8_SB(1, 1), b3 + hstep, voffB); PG8_STAGE(PG8_SA(1, 0), a3, voffA);
            PG8_WAIT_V(8); PG8_WAIT_L(0); PG8_BAR; PG8_MMA(1, 0, At, B0); PG8_MMA(1, 1, At, B1); PG8_BAR; PG8_SCHED;
            } else {
            PG8_LDB(B0, 0, 0); PG8_SCHED; PG8_LDA(At, 0, 0); PG8_STAGE(PG8_SA(1, 1), a1 + hstep, voffA);
            PG8_WAIT_L(8); PG8_BAR; PG8_WAIT_L(0); PG8_MMA(0, 0, At, B0); PG8_BAR; PG8_SCHED;
            PG8_LDB(B1, 0, 1); PG8_STAGE(PG8_SB(0, 0), b2, voffB);
            PG8_BAR; PG8_WAIT_L(0); PG8_MMA(0, 1, At, B1); PG8_BAR;
            PG8_LDA(At, 0, 1); PG8_STAGE(PG8_SA(0, 0), a2, voffA);
            PG8_BAR; PG8_WAIT_L(0); PG8_MMA(1, 0, At, B0); PG8_BAR; PG8_SCHED;
            PG8_STAGE(PG8_SB(0, 1), b2 + hstep, voffB);
            PG8_WAIT_V(6); PG8_BAR; PG8_MMA(1, 1, At, B1); PG8_BAR;
            PG8_LDB(B0, 1, 0); PG8_SCHED; PG8_LDA(At, 1, 0); PG8_STAGE(PG8_SA(0, 1), a2 + hstep, voffA);
            PG8_WAIT_L(8); PG8_BAR; PG8_WAIT_L(0); PG8_MMA(0, 0, At, B0); PG8_BAR; PG8_SCHED;
            PG8_LDB(B1, 1, 1); PG8_STAGE(PG8_SB(1, 0), b3, voffB);
            PG8_BAR; PG8_WAIT_L(0); PG8_MMA(0, 1, At, B1); PG8_BAR;
            PG8_LDA(At, 1, 1); PG8_STAGE(PG8_SA(1, 0), a3, voffA);
            PG8_BAR; PG8_WAIT_L(0); PG8_MMA(1, 0, At, B0); PG8_BAR; PG8_SCHED;
            PG8_STAGE(PG8_SB(1, 1), b3 + hstep, voffB);
            PG8_WAIT_V(6); PG8_BAR; PG8_MMA(1, 1, At, B1); PG8_BAR;
            }
        }
        if constexpr (ALIGN_EPI) { if (wr == 0) PG8_BAR; }
        if constexpr (!Epi::AFTER_DRAIN) { E(acc, cur, ui, wr, wc, fr, fq); S.done(cur); }
        if (!has_next) break;
#pragma unroll
        for (int a = 0; a < 2; ++a)
#pragma unroll
            for (int b = 0; b < 2; ++b)
#pragma unroll
                for (int m = 0; m < 4; ++m)
#pragma unroll
                    for (int n = 0; n < 2; ++n) acc[a][b][m][n] = (f32x4){0.f, 0.f, 0.f, 0.f};
        cur = nxt; cA = nA; cB = nB; ++ui;
        if constexpr (ALIGN_EPI) { if (wr == 1) PG8_BAR; }
    }
    PG8_WAIT_V(0);
    if constexpr (!ALIGN_EPI) { if (wr == 0) PG8_BAR; }
    PG8_BAR;
    if constexpr (Epi::AFTER_DRAIN) { E.fused(acc, cur, wr, wc, fr, fq, lds, wid, lane); S.done(cur); }
#undef PG8_SA
#undef PG8_SB
#undef PG8_STAGE
#undef PG8_LDA
#undef PG8_LDB
#undef PG8_MMA
#undef PG8_WAIT_V
#undef PG8_WAIT_L
#undef PG8_BAR
#undef PG8_SCHED
}
}

constexpr int NWAVES = 8, NTHR = NWAVES * 64;
constexpr int BATCH = 8, SEQ = 4096, D = 1024, FF = 2816, M = BATCH * SEQ;
constexpr int KCONF = 31;
constexpr float RMS_EPS = 1e-6f, LN_EPS = 1e-5f;
constexpr int NPHASE = 12;
constexpr size_t MiB = 1u << 20;
constexpr size_t WS_STATS = 1 * MiB;
constexpr size_t WS_WIN = 4 * MiB, WS_WOUT = 10 * MiB, WS_PW1 = 12 * MiB, WS_PW2 = 16 * MiB;
constexpr size_t WS_WGU0 = 18 * MiB, WS_WGU1 = 29 * MiB, WS_WDN0 = 40 * MiB, WS_WDN1 = 46 * MiB;
constexpr size_t WS_XB = 64 * MiB;
constexpr size_t WS_BG = 128 * MiB, WS_CV = 192 * MiB, WS_Y = 256 * MiB;
constexpr size_t WS_GU = 320 * MiB;
constexpr size_t WS_END = 496 * MiB;
static_assert(WS_WDN1 + (size_t)D * FF * 2 <= WS_XB && WS_WGU0 + (size_t)2 * FF * D * 2 <= WS_WGU1 && WS_WDN0 + (size_t)D * FF * 2 <= WS_WDN1 && WS_GU + (size_t)M * FF * 2 <= WS_END, "d_ws map");
constexpr int RING_BYTES = 131072;
constexpr int RSL_OFF = RING_BYTES + 4096;
constexpr int LDS_BYTES = 147456;

#define GAS __attribute__((address_space(1)))
#define LAS __attribute__((address_space(3)))
typedef unsigned short bf16;
typedef unsigned v4u __attribute__((ext_vector_type(4)));
typedef unsigned v2u __attribute__((ext_vector_type(2)));
typedef float f32x4 __attribute__((ext_vector_type(4)));
typedef float f32x2 __attribute__((ext_vector_type(2)));
#define LDS_WAIT() asm volatile("s_waitcnt lgkmcnt(0)" ::: "memory")
__device__ __forceinline__ unsigned f2bf(float f) { unsigned u = __builtin_bit_cast(unsigned, f); return (u + 0x7fffu + ((u >> 16) & 1u)) >> 16; }
__device__ __forceinline__ unsigned pk2(float lo, float hi) { return pg8::cvt_pk_bf16(lo, hi); }
__device__ __forceinline__ float bf_lo(unsigned u) { return __builtin_bit_cast(float, u << 16); }
__device__ __forceinline__ float bf_hi(unsigned u) { return __builtin_bit_cast(float, u & 0xffff0000u); }
template <int CTRL> __device__ __forceinline__ float dpp_mov(float v) { return __builtin_bit_cast(float, __builtin_amdgcn_update_dpp(0, __builtin_bit_cast(int, v), CTRL, 0xF, 0xF, false)); }
__device__ __forceinline__ float wave_sum(float v) {
    v += dpp_mov<0xB1>(v); v += dpp_mov<0x4E>(v); v += dpp_mov<0x124>(v); v += dpp_mov<0x128>(v);
    const int iv = __builtin_bit_cast(int, v);
    const float a = __builtin_bit_cast(float, __builtin_amdgcn_readlane(iv, 0)), b = __builtin_bit_cast(float, __builtin_amdgcn_readlane(iv, 16));
    const float c = __builtin_bit_cast(float, __builtin_amdgcn_readlane(iv, 32)), d = __builtin_bit_cast(float, __builtin_amdgcn_readlane(iv, 48));
    return (a + b) + (c + d);
}
__device__ __forceinline__ float sigm(float x) { return __builtin_amdgcn_rcpf(1.0f + __builtin_amdgcn_exp2f(-1.4426950408889634f * x)); }

#define XB_TMO      128
#define XB_XCNT(j)  (256  + 64 * (j))
#define XB_XSUB(j)  (1280 + 64 * (j))
#define XB_XGEN(j)  (2304 + 64 * (j))
#define XB_TOP      3328
#define XB_TOPGEN   3392
#define XCD_BAR_WORDS 3456
#define XB_SPIN_CAP (1u << 18)

__device__ __forceinline__ unsigned xb_ld(unsigned* p)              { return __hip_atomic_load(p, __ATOMIC_RELAXED, __HIP_MEMORY_SCOPE_AGENT); }
__device__ __forceinline__ unsigned xb_add(unsigned* p, unsigned v) { return __hip_atomic_fetch_add(p, v, __ATOMIC_RELAXED, __HIP_MEMORY_SCOPE_AGENT); }
__device__ __forceinline__ unsigned xb_xcc_id() { return (unsigned)__builtin_amdgcn_s_getreg((3 << 11) | 20) & 0xFu; }
#define XB_SPIN(cond, bar) do { unsigned _sp = 0; while (cond) { __builtin_amdgcn_s_sleep(1); \
    if ((++_sp & 255u) == 0u) { if (xb_ld(&(bar)[XB_TMO])) break; if (_sp > XB_SPIN_CAP) { atomicAdd(&(bar)[XB_TMO], 1u); break; } } } } while (0)

struct XcdBarrier {
    unsigned* bar; unsigned x;
    volatile LAS unsigned* st;
};

__device__ __forceinline__ XcdBarrier xcd_barrier_post(unsigned* bar, volatile LAS unsigned* st) {
    XcdBarrier b; b.bar = bar; b.x = xb_xcc_id(); b.st = st;
    if (threadIdx.x == 0) (void)xb_add(&bar[XB_XCNT(b.x)], 1u);
    return b;
}
__device__ __forceinline__ void xcd_barrier_complete(unsigned* bar, unsigned x, unsigned& nloc, unsigned& nx) {
    const unsigned G = gridDim.x * gridDim.y * gridDim.z;
    unsigned sum, cnt, mine, sp = 0u;
    for (;;) {
        sum = 0u; cnt = 0u; mine = 0u;
#pragma unroll
        for (unsigned j = 0; j < 16; ++j) { const unsigned c = xb_ld(&bar[XB_XCNT(j)]); sum += c; cnt += (c > 0u) ? 1u : 0u; mine = (j == x) ? c : mine; }
        if (sum == G) break;
        __builtin_amdgcn_s_sleep(1);
        if ((++sp & 255u) == 0u) { if (xb_ld(&bar[XB_TMO])) break; if (sp > XB_SPIN_CAP) { atomicAdd(&bar[XB_TMO], 1u); break; } }
    }
    nloc = mine > 0u ? mine : 1u; nx = cnt > 0u ? cnt : 1u;
}

__device__ __forceinline__ void xcd_barrier(const XcdBarrier& b, bool local) {
    asm volatile("s_waitcnt vmcnt(0)" ::: "memory");
    __syncthreads();
    if (threadIdx.x == 0) {
        unsigned* bar = b.bar;
        __builtin_amdgcn_s_waitcnt(0);
        unsigned nloc = b.st[0], nx = b.st[1];
        if (nloc == 0u) { xcd_barrier_complete(bar, b.x, nloc, nx); b.st[0] = nloc; b.st[1] = nx; }
        const unsigned old = xb_add(&bar[XB_XSUB(b.x)], 1u);
        const unsigned gen = old / nloc;
        if (old + 1u == (gen + 1u) * nloc) {
          if (!local) {
            __builtin_amdgcn_fence(__ATOMIC_RELEASE, "agent");
            asm volatile("s_waitcnt vmcnt(0)" ::: "memory");
            const unsigned og = xb_add(&bar[XB_TOP], 1u);
            const unsigned tg = og / nx;
            if (og + 1u == (tg + 1u) * nx) xb_add(&bar[XB_TOPGEN], 1u);
            else XB_SPIN(xb_ld(&bar[XB_TOPGEN]) == tg, bar);
          }
            __builtin_amdgcn_fence(__ATOMIC_ACQUIRE, "agent");
            xb_add(&bar[XB_XGEN(b.x)], 1u);
            asm volatile("s_waitcnt vmcnt(0)" ::: "memory");
        } else {
            XB_SPIN(xb_ld(&bar[XB_XGEN(b.x)]) == gen, bar);
            __builtin_amdgcn_fence(__ATOMIC_ACQUIRE, "agent");
            asm volatile("s_waitcnt vmcnt(0)" ::: "memory");
        }
    }
    __syncthreads();
}

__device__ __forceinline__ void p0_transpose_item(const float* W, int K, int N, const float* gain, bf16* WT, int kb, int n0, int drow0, LAS float* scr, int lane) {
    const int k0 = 64 * kb;
#pragma unroll 8
    for (int i = 0; i < 32; ++i) { const int kk = 2 * i + (lane >> 5); scr[kk * 33 + (lane & 31)] = __builtin_nontemporal_load(W + (size_t)(k0 + kk) * N + n0 + (lane & 31)); }
    LDS_WAIT(); asm volatile("" ::: "memory");
    const int c = lane & 7;
    float gk[8];
#pragma unroll
    for (int e = 0; e < 8; ++e) gk[e] = gain ? gain[k0 + 8 * c + e] : 1.0f;
#pragma unroll
    for (int j = 0; j < 4; ++j) { const int n = (lane >> 3) + 8 * j; const LAS float* s = scr + (8 * c) * 33 + n;
        v4u o; o.x = pk2(s[0 * 33] * gk[0], s[1 * 33] * gk[1]); o.y = pk2(s[2 * 33] * gk[2], s[3 * 33] * gk[3]); o.z = pk2(s[4 * 33] * gk[4], s[5 * 33] * gk[5]); o.w = pk2(s[6 * 33] * gk[6], s[7 * 33] * gk[7]);
        __builtin_nontemporal_store(o, (GAS v4u*)(WT + (size_t)(drow0 + n) * K + k0 + 8 * c)); }
    LDS_WAIT(); asm volatile("" ::: "memory");
}
__device__ __forceinline__ int inter128(int j, int h) { return 256 * (j >> 7) + 128 * h + (j & 127); }

#define FILL_RSL(S) do { LAS float* rsl_ = (LAS float*)(lds + RSL_OFF); f32x4 t_[6]; \
        _Pragma("unroll") for (int j_ = 0; j_ < 6; ++j_) { pg8::Unit u_; t_[j_] = (f32x4){1.f, 1.f, 1.f, 1.f};        \
            if (S.next((tid >> 8) + 2 * j_, u_)) t_[j_] = *(const f32x4*)(STATS + (size_t)(u_.pm * 256 + (tid & 255)) * pg8::NSTAT); } \
        _Pragma("unroll") for (int j_ = 0; j_ < 6; ++j_) rsl_[((tid >> 8) + 2 * j_) * 256 + (tid & 255)] = 1.0f / sqrtf(((t_[j_][0] + t_[j_][1]) + (t_[j_][2] + t_[j_][3])) * (1.0f / D) + RMS_EPS); \
        __syncthreads(); } while (0)
struct Args { const float* in[19]; float* out; unsigned char* ws; int ph_lo, ph_hi; };

__global__ void __launch_bounds__(NTHR, 2) trunk_fwd(Args args) {
    extern __shared__ __attribute__((aligned(16))) unsigned char lds_raw[];
    LAS unsigned char* lds = (LAS unsigned char*)lds_raw;
    const int tid = threadIdx.x, lane = tid & 63, wave = __builtin_amdgcn_readfirstlane(tid >> 6);
    const int G = gridDim.x, bid = blockIdx.x;
    unsigned char* ws = args.ws;
    const float* x = args.in[0];
    const float *a_norm = args.in[1], *a_w_in = args.in[2], *a_conv = args.in[3], *a_w_out = args.in[4];
    const float *b_norm = args.in[5], *b_w_pw1 = args.in[6], *b_b_pw1 = args.in[7], *b_conv = args.in[8], *b_b_conv = args.in[9], *b_ln_g = args.in[10], *b_ln_b = args.in[11], *b_w_pw2 = args.in[12], *b_b_pw2 = args.in[13];
    const float *ffn_norm = args.in[14], *ffn_w_gate = args.in[15], *ffn_w_up = args.in[16], *ffn_w_down = args.in[17], *final_norm = args.in[18];
    float* out = args.out;
    float* STATS = (float*)(ws + WS_STATS);
    bf16 *Win_t = (bf16*)(ws + WS_WIN), *Wout_t = (bf16*)(ws + WS_WOUT), *Wpw1_t = (bf16*)(ws + WS_PW1), *Wpw2_t = (bf16*)(ws + WS_PW2);
    bf16 *XB = (bf16*)(ws + WS_XB), *BG = (bf16*)(ws + WS_BG), *CV = (bf16*)(ws + WS_CV), *Y = (bf16*)(ws + WS_Y), *GU = (bf16*)(ws + WS_GU);
    const int lo = args.ph_lo, hi = args.ph_hi;
#if !MK_PER_PHASE
    volatile LAS unsigned* bst = (volatile LAS unsigned*)(lds + RING_BYTES);
    if (tid < 4) bst[tid] = 0u;
    __syncthreads();
    XcdBarrier bar; bar.bar = (unsigned*)ws; bar.x = xb_xcc_id(); bar.st = bst;
    if (tid == 0) bst[2] = xb_add(&bar.bar[XB_XCNT(bar.x)], 1u);
    if (lo < 0) cg::this_grid().sync();
#endif
#define IN(k) (lo <= (k) && (k) < hi)
#if MK_PER_PHASE
#define XLOCAL() false
#define VBLK() bid
#define CVID() bid
#else
#define XLOCAL() ((__builtin_amdgcn_readfirstlane(bst[3]) >> 16) != 0)
#define VBLK() ((int)((__builtin_amdgcn_readfirstlane(bst[3]) >> 16) ? (__builtin_amdgcn_readfirstlane(bst[3]) & 0xffffu) : (unsigned)bid))
#define CVID() ((int)((__builtin_amdgcn_readfirstlane(bst[3]) >> 16) ? ((__builtin_amdgcn_readfirstlane(bst[3]) & 31u) * 8u + ((__builtin_amdgcn_readfirstlane(bst[3]) & 0xffffu) >> 5)) : (unsigned)bid))
#endif
#if MK_PER_PHASE
#define SEAM(k) do { } while (0)
#else
#define SEAM(k) do { if (IN(k) && IN((k) + 1)) { xcd_barrier(bar, XLOCAL()); } } while (0)
#endif

    if (IN(0)) {
        LAS float* scr = (LAS float*)(lds + wave * 16384);
        const int gw = bid * NWAVES + wave, NGW = G * NWAVES;
        constexpr int I_IN = 16 * 96, I_SQ = 16 * 32, I_PW1 = 16 * 64, I_GU = 16 * 88, I_DN = 44 * 32;
        constexpr int NITEMS = I_IN + 2 * I_SQ + I_PW1 + 4 * I_GU + 2 * I_DN;
        for (int it = gw; it < NITEMS; it += NGW) {
            int r = it;
            if (r < I_IN) { const int kb = r / 96, n0 = 32 * (r % 96); const int dr = n0 < 1024 ? 2048 + n0 : (n0 < 2048 ? inter128(n0 - 1024, 0) : inter128(n0 - 2048, 1));
                p0_transpose_item(a_w_in, D, 3 * D, a_norm, Win_t, kb, n0, dr, scr, lane); continue; } r -= I_IN;
            if (r < I_SQ) { const int kb = r / 32, n0 = 32 * (r % 32); p0_transpose_item(a_w_out, D, D, nullptr, Wout_t, kb, n0, n0, scr, lane); continue; } r -= I_SQ;
            if (r < I_SQ) { const int kb = r / 32, n0 = 32 * (r % 32); p0_transpose_item(b_w_pw2, D, D, nullptr, Wpw2_t, kb, n0, n0, scr, lane); continue; } r -= I_SQ;
            if (r < I_PW1) { const int kb = r / 64, n0 = 32 * (r % 64); const int dr = n0 < 1024 ? inter128(n0, 0) : inter128(n0 - 1024, 1);
                p0_transpose_item(b_w_pw1, D, 2 * D, b_norm, Wpw1_t, kb, n0, dr, scr, lane); continue; } r -= I_PW1;
            if (r < 4 * I_GU) { const int q = r / I_GU, rr = r % I_GU, layer = q >> 1, hsel = q & 1; const int kb = rr / 88, n0 = 32 * (rr % 88);
                const float* W = (hsel ? ffn_w_up : ffn_w_gate) + (size_t)layer * D * FF; bf16* WT = (bf16*)(ws + (layer ? WS_WGU1 : WS_WGU0));
                p0_transpose_item(W, D, FF, ffn_norm + layer * D, WT, kb, n0, inter128(n0, hsel), scr, lane); continue; } r -= 4 * I_GU;
            { const int layer = r / I_DN, rr = r % I_DN; const int kb = rr / 32, n0 = 32 * (rr % 32);
                p0_transpose_item(ffn_w_down + (size_t)layer * FF * D, FF, D, nullptr, (bf16*)(ws + (layer ? WS_WDN1 : WS_WDN0)), kb, n0, n0, scr, lane); }
        }
        for (int m = gw; m < M; m += NGW) {
            const GAS f32x4* xr = (const GAS f32x4*)(x + (size_t)m * D) + lane; f32x4 v[4]; float s = 0.f;
#pragma unroll
            for (int j = 0; j < 4; ++j) { v[j] = __builtin_nontemporal_load(xr + 64 * j); s += (v[j].x * v[j].x + v[j].y * v[j].y) + (v[j].z * v[j].z + v[j].w * v[j].w); }
            s = wave_sum(s);
            GAS v2u* o8 = (GAS v2u*)(XB + (size_t)m * D) + lane;
#pragma unroll
            for (int j = 0; j < 4; ++j) { v2u o; o.x = pk2(v[j].x, v[j].y); o.y = pk2(v[j].z, v[j].w); __builtin_nontemporal_store(o, o8 + 64 * j); }
            if (lane == 0) *(GAS f32x4*)(STATS + (size_t)m * pg8::NSTAT) = (f32x4){s, 0.f, 0.f, 0.f};
        }
    }
    SEAM(0);
#if !MK_PER_PHASE
    if (IN(0) && IN(1)) {
        if (tid == 0) { unsigned ok = (G == 256) ? 1u : 0u, npop = 0u, xi = 0u;
            for (unsigned j = 0; j < 16; ++j) { const unsigned c = xb_ld(&bar.bar[XB_XCNT(j)]); if (c) { ok &= (c == 32u) ? 1u : 0u; ++npop; if (j < bar.x) ++xi; } }
            ok &= (npop == 8u) ? 1u : 0u;
            bst[3] = ok ? (0x10000u | (xi * 32u + bst[2])) : 0u; }
        __syncthreads();
    }
#endif
    if (IN(1)) {
        pg8::Gemm g{XB, Win_t, M, 3 * D, D}; pg8::StaticOrder S; S.init(M, 3 * D, G, CVID());
        FILL_RSL(S); pg8::EpiPair<2> E{CV, D, BG, (const LAS float*)(lds + RSL_OFF), nullptr};
        pg8::gemm_phase<pg8::EpiPair<2>, pg8::StaticOrder, true, true>(lds, g, S, E);
    }
    SEAM(1);
    if (IN(2)) {
        const int cg8 = tid & 127, sub = tid >> 7;
        float w0[8], w1[8], w2[8];
#pragma unroll
        for (int e = 0; e < 8; ++e) { w0[e] = a_conv[8 * cg8 + e]; w1[e] = a_conv[D + 8 * cg8 + e]; w2[e] = a_conv[2 * D + 8 * cg8 + e]; }
        constexpr int CH = 32;
        for (int chunk = VBLK() * 4 + sub; chunk < M / CH; chunk += G * 4) {
            const int t0 = chunk * CH; const bool first = (t0 & (SEQ - 1)) == 0;
            const GAS v4u* cvp = (const GAS v4u*)(CV + (size_t)t0 * D + 8 * cg8); const GAS v4u* bgp = (const GAS v4u*)(BG + (size_t)t0 * D + 8 * cg8); GAS v4u* yp = (GAS v4u*)(Y + (size_t)t0 * D + 8 * cg8);
            float p2[8], p1[8];
            { v4u a = (v4u){0u, 0u, 0u, 0u}, b = a; if (!first) { a = cvp[-2 * (D / 8)]; b = cvp[-1 * (D / 8)]; }
#pragma unroll
              for (int e = 0; e < 4; ++e) { p2[2 * e] = bf_lo(a[e]); p2[2 * e + 1] = bf_hi(a[e]); p1[2 * e] = bf_lo(b[e]); p1[2 * e + 1] = bf_hi(b[e]); } }
#pragma unroll 8
            for (int t = 0; t < CH; ++t) {
                const v4u c = __builtin_nontemporal_load(cvp + t * (D / 8)), bgv = __builtin_nontemporal_load(bgp + t * (D / 8)); float cur[8], o[8];
#pragma unroll
                for (int e = 0; e < 4; ++e) { cur[2 * e] = bf_lo(c[e]); cur[2 * e + 1] = bf_hi(c[e]); }
#pragma unroll
                for (int e = 0; e < 4; ++e) { o[2 * e] = bf_lo(bgv[e]) * (w0[2 * e] * p2[2 * e] + w1[2 * e] * p1[2 * e] + w2[2 * e] * cur[2 * e]);
                                              o[2 * e + 1] = bf_hi(bgv[e]) * (w0[2 * e + 1] * p2[2 * e + 1] + w1[2 * e + 1] * p1[2 * e + 1] + w2[2 * e + 1] * cur[2 * e + 1]); }
                v4u ov; ov.x = pk2(o[0], o[1]); ov.y = pk2(o[2], o[3]); ov.z = pk2(o[4], o[5]); ov.w = pk2(o[6], o[7]);
                __builtin_nontemporal_store(ov, yp + t * (D / 8));
#pragma unroll
                for (int e = 0; e < 8; ++e) { p2[e] = p1[e]; p1[e] = cur[e]; }
            }
        }
    }
    SEAM(2);
    if (IN(3)) {
        pg8::Gemm g{Y, Wout_t, M, D, D}; pg8::StaticOrder S; S.init(M, D, G, CVID());
        pg8::EpiRes E{XB, STATS, nullptr, (LAS float*)(lds + RSL_OFF)};
        pg8::gemm_phase<pg8::EpiRes, pg8::StaticOrder, true, true>(lds, g, S, E);
    }
    SEAM(3);
    if (IN(4)) {
        pg8::Gemm g{XB, (const bf16*)(ws + WS_WGU0), M, 2 * FF, D}; pg8::StaticOrder S; S.init(M, 2 * FF, G, CVID());
        FILL_RSL(S); pg8::EpiPair<0> E{GU, FF, nullptr, (const LAS float*)(lds + RSL_OFF), nullptr};
        pg8::gemm_phase<pg8::EpiPair<0>, pg8::StaticOrder, true, true>(lds, g, S, E);
    }
    SEAM(4);
    if (IN(5)) {
        pg8::Gemm g{GU, (const bf16*)(ws + WS_WDN0), M, D, FF}; pg8::StaticOrder S; S.init(M, D, G, CVID());
        pg8::EpiRes E{XB, STATS, nullptr, (LAS float*)(lds + RSL_OFF)};
        pg8::gemm_phase<pg8::EpiRes, pg8::StaticOrder, true, true>(lds, g, S, E);
    }
    SEAM(5);
    if (IN(6)) {
        pg8::Gemm g{XB, Wpw1_t, M, 2 * D, D}; pg8::StaticOrder S; S.init(M, 2 * D, G, CVID());
        FILL_RSL(S); pg8::EpiPair<1> E{BG, D, nullptr, (const LAS float*)(lds + RSL_OFF), b_b_pw1};
        pg8::gemm_phase<pg8::EpiPair<1>, pg8::StaticOrder, true, true>(lds, g, S, E);
    }
    SEAM(6);
    if (IN(7)) {
        const int c0 = 2 * tid;
        f32x2 w[KCONF];
#pragma unroll
        for (int k = 0; k < KCONF; ++k) w[k] = *(const f32x2*)(b_conv + k * D + c0);
        const f32x2 cb = *(const f32x2*)(b_b_conv + c0);
        f32x4 lng4[4], lnb4[4];
#pragma unroll
        for (int j = 0; j < 4; ++j) { lng4[j] = *(const f32x4*)(b_ln_g + 4 * lane + 256 * j); lnb4[j] = *(const f32x4*)(b_ln_b + 4 * lane + 256 * j); }
        constexpr int TT = 16, NTILE = M / TT; const int per = (NTILE + G - 1) / G, tb = VBLK() * per, te = (tb + per < NTILE) ? tb + per : NTILE, nt_ = te - tb;
        unsigned xr[30 + TT];
        if (nt_ > 0) { const int t0 = tb * TT; const bool first = (t0 & (SEQ - 1)) == 0; const GAS unsigned* src = (const GAS unsigned*)(BG + (size_t)t0 * D + c0);
#pragma unroll
            for (int s = 0; s < 30 + TT; ++s) { const bool pad = first && s < 30; const unsigned u = src[(long)(pad ? 0 : s - 30) * (D / 2)]; xr[s] = pad ? 0u : u; } }
#define P7_CONV(i_) do { f32x2 acc[TT]; \
            _Pragma("unroll") for (int t = 0; t < TT; ++t) acc[t] = cb; \
            _Pragma("unroll") for (int s = 0; s < 30 + TT; ++s) { const f32x2 xv = (f32x2){bf_lo(xr[s]), bf_hi(xr[s])}; \
                _Pragma("unroll") for (int t = (s > 30 ? s - 30 : 0); t <= (s < TT ? s : TT - 1); ++t) acc[t] += w[s - t] * xv; } \
            LAS float* Tw = (LAS float*)(lds + ((i_) & 1) * 65536); \
            _Pragma("unroll") for (int t = 0; t < TT; ++t) *(LAS f32x2*)(Tw + t * D + c0) = acc[t]; } while (0)
#define P7_LN(i_) do { const LAS float* Tr = (const LAS float*)(lds + ((i_) & 1) * 65536); const int tbase = (tb + (i_)) * TT; \
            _Pragma("unroll") for (int q = 0; q < 2; ++q) { const int t = wave * 2 + q; f32x4 v[4]; float s = 0.f, s2 = 0.f; \
                _Pragma("unroll") for (int j = 0; j < 4; ++j) { v[j] = *(const LAS f32x4*)(Tr + t * D + 4 * lane + 256 * j); s += (v[j].x + v[j].y) + (v[j].z + v[j].w); s2 += (v[j].x * v[j].x + v[j].y * v[j].y) + (v[j].z * v[j].z + v[j].w * v[j].w); } \
                const float mean = wave_sum(s) * (1.f / D); const float var = fmaxf(wave_sum(s2) * (1.f / D) - mean * mean, 0.f); \
                const float rstd = 1.f / sqrtf(var + LN_EPS); \
                GAS v2u* o8 = (GAS v2u*)(CV + (size_t)(tbase + t) * D) + lane; \
                _Pragma("unroll") for (int j = 0; j < 4; ++j) { const f32x4 gg = lng4[j], bb = lnb4[j]; \
                    f32x4 y = (v[j] - mean) * rstd * gg + bb; y.x *= sigm(y.x); y.y *= sigm(y.y); y.z *= sigm(y.z); y.w *= sigm(y.w); \
                    v2u o; o.x = pk2(y.x, y.y); o.y = pk2(y.z, y.w); __builtin_nontemporal_store(o, o8 + 64 * j); } } } while (0)
        for (int i = 0; i <= nt_; ++i) {
            unsigned xn[TT];
            if (i + 1 < nt_) { const GAS unsigned* src = (const GAS unsigned*)(BG + (size_t)((tb + i + 1) * TT) * D + c0);
#pragma unroll
                for (int s = 0; s < TT; ++s) xn[s] = __builtin_nontemporal_load(src + (long)s * (D / 2)); }
            else {
#pragma unroll
                for (int s = 0; s < TT; ++s) xn[s] = 0u; }
            if (i == 0) { P7_CONV(i); }
            else if (i == nt_) { P7_LN(i - 1); }
            else if (wave < 4) { P7_CONV(i); P7_LN(i - 1); }
            else { P7_LN(i - 1); P7_CONV(i); }
            __syncthreads();
            const bool nfirst = (((tb + i + 1) * TT) & (SEQ - 1)) == 0;
#pragma unroll
            for (int s = 0; s < 30; ++s) xr[s] = nfirst ? 0u : xr[s + TT];
#pragma unroll
            for (int s = 0; s < TT; ++s) xr[30 + s] = xn[s];
        }
#undef P7_CONV
#undef P7_LN
    }
    SEAM(7);
    if (IN(8)) {
        pg8::Gemm g{CV, Wpw2_t, M, D, D}; pg8::StaticOrder S; S.init(M, D, G, CVID());
        pg8::EpiRes E{XB, STATS, b_b_pw2, (LAS float*)(lds + RSL_OFF)};
        pg8::gemm_phase<pg8::EpiRes, pg8::StaticOrder, true, true>(lds, g, S, E);
    }
    SEAM(8);
    if (IN(9)) {
        pg8::Gemm g{XB, (const bf16*)(ws + WS_WGU1), M, 2 * FF, D}; pg8::StaticOrder S; S.init(M, 2 * FF, G, CVID());
        FILL_RSL(S); pg8::EpiPair<0> E{GU, FF, nullptr, (const LAS float*)(lds + RSL_OFF), nullptr};
        pg8::gemm_phase<pg8::EpiPair<0>, pg8::StaticOrder, true, true>(lds, g, S, E);
    }
    SEAM(9);
    if (IN(10)) {
        pg8::Gemm g{GU, (const bf16*)(ws + WS_WDN1), M, D, FF}; pg8::StaticOrder S; S.init(M, D, G, CVID());
        pg8::EpiRes E{XB, STATS, nullptr, (LAS float*)(lds + RSL_OFF)};
        pg8::gemm_phase<pg8::EpiRes, pg8::StaticOrder, true, true>(lds, g, S, E);
    }
    SEAM(10);
    if (IN(11)) {
        const int gw = bid * NWAVES + wave, NGW = G * NWAVES;
        f32x4 gn[4];
#pragma unroll
        for (int j = 0; j < 4; ++j) gn[j] = *(const f32x4*)(final_norm + 4 * lane + 256 * j);
        const int vblk11 = VBLK();
        for (int mi = 0; mi < (M / 128 + G - 1) / G * 16; ++mi) { const int blk_ = vblk11 + (mi >> 4) * G; if (blk_ >= M / 128) break; const int m = blk_ * 128 + wave * 16 + (mi & 15);
            const GAS v2u* hr = (const GAS v2u*)(XB + (size_t)m * D) + lane; v2u hv[4];
#pragma unroll
            for (int j = 0; j < 4; ++j) hv[j] = __builtin_nontemporal_load(hr + 64 * j);
            float s = lane < pg8::NSTAT ? STATS[(size_t)m * pg8::NSTAT + lane] : 0.f;
            s += __shfl_xor(s, 1); s += __shfl_xor(s, 2);
            const float r = 1.f / sqrtf(__shfl(s, 0) * (1.f / D) + RMS_EPS);
            GAS f32x4* orow = (GAS f32x4*)(out + (size_t)m * D) + lane;
#pragma unroll
            for (int j = 0; j < 4; ++j) { const f32x4 v = (f32x4){bf_lo(hv[j].x), bf_hi(hv[j].x), bf_lo(hv[j].y), bf_hi(hv[j].y)}; __builtin_nontemporal_store(v * r * gn[j], orow + 64 * j); }
        }
    }
#undef IN
#undef SEAM
}

extern "C" void kernel_launch(void* const* d_in, const int* in_sizes, int n_in, void* d_out, int out_size, void* d_ws, size_t ws_size, hipStream_t stream) {
    static int grid = 0;
    if (grid == 0) {
        if (n_in != 19 || in_sizes[0] != M * D || out_size != M * D || ws_size < WS_END) { fprintf(stderr, "kernel_launch: shape/workspace mismatch: n_in %d in0 %d out %d ws %zu (need %zu); nothing launched\n", n_in, n_in > 0 ? in_sizes[0] : -1, out_size, ws_size, (size_t)WS_END); grid = -1; return; }
        int dev = 0, cus = 0, per_cu = 0;
        if (hipGetDevice(&dev) != hipSuccess || hipDeviceGetAttribute(&cus, hipDeviceAttributeMultiprocessorCount, dev) != hipSuccess) { fprintf(stderr, "kernel_launch: device query failed\n"); grid = -1; return; }
        if (hipFuncSetAttribute((const void*)trunk_fwd, hipFuncAttributeMaxDynamicSharedMemorySize, LDS_BYTES) != hipSuccess) { fprintf(stderr, "kernel_launch: hipFuncSetAttribute failed\n"); grid = -1; return; }
        if (hipOccupancyMaxActiveBlocksPerMultiprocessor(&per_cu, (const void*)trunk_fwd, NTHR, LDS_BYTES) != hipSuccess || per_cu < 1) { fprintf(stderr, "kernel_launch: occupancy query says %d blocks/CU; using 1\n", per_cu); per_cu = 1; }
        (void)hipGetLastError();
        grid = cus * per_cu;
    }
    if (grid < 0) return;
    Args a{};
    for (int i = 0; i < 19; ++i) a.in[i] = (const float*)d_in[i];
    a.out = (float*)d_out; a.ws = (unsigned char*)d_ws;
#if MK_PER_PHASE
    for (int p = 0; p < NPHASE; ++p) { a.ph_lo = p; a.ph_hi = p + 1; hipLaunchKernelGGL(trunk_fwd, dim3(grid), dim3(NTHR), LDS_BYTES, stream, a); }
#else
    a.ph_lo = 0; a.ph_hi = NPHASE;
    if (hipMemsetAsync(d_ws, 0, 16384, stream) != hipSuccess) { fprintf(stderr, "kernel_launch: memset of the barrier words failed\n"); return; }
    void* kargs[] = {&a};
    hipError_t e = hipLaunchCooperativeKernel((const void*)trunk_fwd, dim3(grid), dim3(NTHR), kargs, LDS_BYTES, stream);
    if (e != hipSuccess) fprintf(stderr, "kernel_launch: cooperative launch failed: %s (grid %d)\n", hipGetErrorString(e), grid);
#if MK_PROBE_PHASE >= 0
    a.ph_lo = MK_PROBE_PHASE; a.ph_hi = MK_PROBE_PHASE + 1; hipLaunchKernelGGL(trunk_fwd, dim3(grid), dim3(NTHR), LDS_BYTES, stream, a);
#endif
#endif
}
```

```cpp
#include <hip/hip_runtime.h>
#include <hip/hip_cooperative_groups.h>
#include <cstdio>
#include <cstdint>
namespace cg = cooperative_groups;
#ifndef MK_PROBE_PHASE
#define MK_PROBE_PHASE -1
#endif
#ifndef MK_PER_PHASE
#define MK_PER_PHASE 0
#endif
namespace pg8 {
#define PG8_LAS __attribute__((address_space(3)))
typedef unsigned short bf16_t;
typedef short bf16x8 __attribute__((ext_vector_type(8)));
typedef float f32x4 __attribute__((ext_vector_type(4)));
typedef unsigned u32x4 __attribute__((ext_vector_type(4)));
constexpr int BM = 256, BK = 64, HALF = 128, HTB = HALF * BK * 2  , STAGE_BYTES = 8 * HTB, NXCD = 8, WGM = 4;

__host__ __device__ __forceinline__ int lds_byte(int r, int c) { const int st = (r >> 4) * 2 + (c >> 5), rr = r & 15, cc = c & 31, ob = rr * 64 + cc * 2; return st * 1024 + (ob ^ (((ob >> 9) & 1) << 5)); }
__host__ __device__ __forceinline__ void stage_rc(int b, int& R, int& C) { const int st = b / 1024, sb = b % 1024, swz = sb ^ (((sb >> 9) & 1) << 5); R = (st >> 1) * 16 + swz / 64; C = (st & 1) * 32 + (swz % 64) / 2; }
__host__ __device__ __forceinline__ int perm32(int rho) { const int n = rho >> 4, i = rho & 15; return 8 * (i >> 2) + 4 * n + (i & 3); }

struct Unit { int pm, pn; };
struct Gemm { const bf16_t* A; const bf16_t* Bt; int M, N, K; };

struct StaticOrder {
    int nM, nN, nwg, G, c;
    __host__ __device__ void init(int M, int N, int G_, int c_) { nM = M / BM; nN = N / BM; nwg = nM * nN; G = G_; c = c_; }
    __host__ __device__ bool next(int i, Unit& u) const {
        const long L = (long)i * G + c; if (L >= nwg) return false;
        int wgid = (int)L; { const int q = nwg / NXCD, r = nwg % NXCD, xcd = wgid % NXCD, off = wgid / NXCD; wgid = (xcd < r ? xcd * (q + 1) : r * (q + 1) + (xcd - r) * q) + off; }
        const int nig = WGM * nN, gid = wgid / nig, fm = gid * WGM, gsz = (nM - fm) < WGM ? (nM - fm) : WGM;
        u.pm = fm + ((wgid % nig) % gsz); u.pn = (wgid % nig) / gsz; return true;
    }
    __device__ __forceinline__ void a_ready(const Unit&) const {}
    __device__ __forceinline__ void done(const Unit&) const {}
};

__device__ __forceinline__ unsigned cvt_pk_bf16(float lo, float hi) { unsigned r; asm volatile("v_cvt_pk_bf16_f32 %0, %1, %2" : "=v"(r) : "v"(lo), "v"(hi)); return r; }
typedef float f32x2 __attribute__((ext_vector_type(2)));
__device__ __forceinline__ float sigmoid_f(float x) { return __builtin_amdgcn_rcpf(1.0f + __builtin_amdgcn_exp2f(-1.4426950408889634f * x)); }
constexpr int NSTAT = 4;
__device__ __forceinline__ void load_rscale(const float* stats, int row0, int fq, float (&rs)[2][4]) {
#pragma unroll
    for (int ai = 0; ai < 2; ++ai)
#pragma unroll
        for (int m = 0; m < 4; ++m) {
            const f32x4 p = *(const f32x4*)(stats + (size_t)(row0 + ai * HALF + m * 16) * NSTAT + fq * 4);
            float s = (p[0] + p[1]) + (p[2] + p[3]); s += __shfl_xor(s, 16); s += __shfl_xor(s, 32);
            rs[ai][m] = 1.0f / sqrtf(s * (1.0f / 1024.0f) + 1e-6f);
        }
}
__device__ __forceinline__ u32x4 pack8(const f32x4 v0, const f32x4 v1) { u32x4 w; w.x = cvt_pk_bf16(v0[0], v0[1]); w.y = cvt_pk_bf16(v0[2], v0[3]); w.z = cvt_pk_bf16(v1[0], v1[1]); w.w = cvt_pk_bf16(v1[2], v1[3]); return w; }
template <int MODE> struct EpiPair {
    static constexpr bool PERM = true, AFTER_DRAIN = false;
    bf16_t* O; int ldc; bf16_t* O2; const PG8_LAS float* rsl; const float* bias;
    __device__ __forceinline__ void operator()(const f32x4 (&acc)[2][2][4][2], const Unit& u, int ui, int wr, int wc, int fr, int fq) const {
        const int row0 = u.pm * BM + wr * 64 + fr, cw = wc * 32 + 8 * fq;
        float rs[2][4];
#pragma unroll
        for (int ai = 0; ai < 2; ++ai)
#pragma unroll
            for (int m = 0; m < 4; ++m) rs[ai][m] = rsl[ui * BM + ai * HALF + wr * 64 + m * 16 + fr];
        if (MODE == 2 && u.pn >= 8) {
#pragma unroll
            for (int ai = 0; ai < 2; ++ai)
#pragma unroll
                for (int m = 0; m < 4; ++m) { const float r = rs[ai][m]; bf16_t* rowp = O2 + (size_t)(row0 + ai * HALF + m * 16) * 1024 + (u.pn - 8) * BM + cw;
#pragma unroll
                    for (int bj = 0; bj < 2; ++bj) __builtin_nontemporal_store(pack8(acc[ai][bj][m][0] * r, acc[ai][bj][m][1] * r), (u32x4*)(rowp + bj * HALF)); }
            return;
        }
        f32x4 bp[2], bq[2];
#pragma unroll
        for (int n = 0; n < 2; ++n) { bp[n] = (f32x4){0.f, 0.f, 0.f, 0.f}; bq[n] = bp[n]; if (MODE == 1) { bp[n] = *(const f32x4*)(bias + u.pn * HALF + cw + 4 * n); bq[n] = *(const f32x4*)(bias + 1024 + u.pn * HALF + cw + 4 * n); } }
#pragma unroll
        for (int ai = 0; ai < 2; ++ai)
#pragma unroll
            for (int m = 0; m < 4; ++m) { const float r = rs[ai][m], r2 = r * r, rc = -1.4426950408889634f * r; bf16_t* rowp = O + (size_t)(row0 + ai * HALF + m * 16) * ldc + u.pn * HALF + cw;
                f32x4 o[2];
#pragma unroll
                for (int n = 0; n < 2; ++n) { const f32x4 ap = acc[ai][0][m][n], aq = acc[ai][1][m][n];
                    if (MODE == 0) { const f32x4 t = ap * rc; f32x4 d; d[0] = __builtin_amdgcn_exp2f(t[0]); d[1] = __builtin_amdgcn_exp2f(t[1]); d[2] = __builtin_amdgcn_exp2f(t[2]); d[3] = __builtin_amdgcn_exp2f(t[3]);
                        d = d + 1.0f; f32x4 s; s[0] = __builtin_amdgcn_rcpf(d[0]); s[1] = __builtin_amdgcn_rcpf(d[1]); s[2] = __builtin_amdgcn_rcpf(d[2]); s[3] = __builtin_amdgcn_rcpf(d[3]);
                        o[n] = (ap * aq) * (s * r2); }
                    else if (MODE == 1) { const f32x4 p = ap * r + bp[n], q = aq * r + bq[n], t = q * (-1.4426950408889634f); f32x4 d; d[0] = __builtin_amdgcn_exp2f(t[0]); d[1] = __builtin_amdgcn_exp2f(t[1]); d[2] = __builtin_amdgcn_exp2f(t[2]); d[3] = __builtin_amdgcn_exp2f(t[3]);
                        d = d + 1.0f; f32x4 s; s[0] = __builtin_amdgcn_rcpf(d[0]); s[1] = __builtin_amdgcn_rcpf(d[1]); s[2] = __builtin_amdgcn_rcpf(d[2]); s[3] = __builtin_amdgcn_rcpf(d[3]);
                        o[n] = p * s; }
                    else o[n] = (ap * aq) * r2; }
                __builtin_nontemporal_store(pack8(o[0], o[1]), (u32x4*)rowp); }
    }
};
struct EpiRes {
    static constexpr bool PERM = true, AFTER_DRAIN = false;
    bf16_t* xb; float* stats; const float* bias; PG8_LAS float* xl;
    __device__ __forceinline__ void operator()(const f32x4 (&acc)[2][2][4][2], const Unit& u, int ui, int wr, int wc, int fr, int fq) const {
        const int row0 = u.pm * BM + wr * 64 + fr, col0 = u.pn * BM + wc * 32 + 8 * fq;
        u32x4 b[2][2][2];
#define RES_LOAD(g) do { _Pragma("unroll") for (int mm = 0; mm < 2; ++mm) _Pragma("unroll") for (int bj = 0; bj < 2; ++bj) \
            b[(g) & 1][mm][bj] = *(const u32x4*)(xb + (size_t)(row0 + ((g) >> 1) * HALF + (2 * ((g) & 1) + mm) * 16) * 1024 + col0 + bj * HALF); } while (0)
        RES_LOAD(0); RES_LOAD(1);
        asm volatile("" ::: "memory");
#pragma unroll
        for (int g = 0; g < 4; ++g) {
#pragma unroll
            for (int mm = 0; mm < 2; ++mm) { const int ai = g >> 1, m = 2 * (g & 1) + mm; const int row = row0 + ai * HALF + m * 16; bf16_t* p = xb + (size_t)row * 1024 + col0; float ss = 0.f;
#pragma unroll
                for (int bj = 0; bj < 2; ++bj) { const u32x4 bb = b[g & 1][mm][bj];
                    const f32x4 b0 = (f32x4){__builtin_bit_cast(float, bb.x << 16), __builtin_bit_cast(float, bb.x & 0xffff0000u), __builtin_bit_cast(float, bb.y << 16), __builtin_bit_cast(float, bb.y & 0xffff0000u)};
                    const f32x4 b1 = (f32x4){__builtin_bit_cast(float, bb.z << 16), __builtin_bit_cast(float, bb.z & 0xffff0000u), __builtin_bit_cast(float, bb.w << 16), __builtin_bit_cast(float, bb.w & 0xffff0000u)};
                    f32x4 v0 = b0 + acc[ai][bj][m][0], v1 = b1 + acc[ai][bj][m][1];
                    if (bias) { v0 += *(const f32x4*)(bias + col0 + bj * HALF); v1 += *(const f32x4*)(bias + col0 + bj * HALF + 4); }
                    ss += (v0[0] * v0[0] + v0[1] * v0[1]) + (v0[2] * v0[2] + v0[3] * v0[3]) + (v1[0] * v1[0] + v1[1] * v1[1]) + (v1[2] * v1[2] + v1[3] * v1[3]);
                    *(u32x4*)(p + bj * HALF) = pack8(v0, v1); }
                ss += __shfl_xor(ss, 16); ss += __shfl_xor(ss, 32); if (fq == 0) xl[wc * BM + ai * HALF + wr * 64 + m * 16 + fr] = ss; }
            asm volatile("" ::: "memory");
            if (g + 2 < 4) { RES_LOAD(g + 2); asm volatile("" ::: "memory"); }
        }
#undef RES_LOAD
        asm volatile("s_waitcnt lgkmcnt(0)" ::: "memory"); __builtin_amdgcn_s_barrier(); asm volatile("" ::: "memory");
        if (threadIdx.x < 256) { const int r = threadIdx.x; stats[(size_t)(u.pm * BM + r) * NSTAT + u.pn] = (xl[r] + xl[BM + r]) + (xl[2 * BM + r] + xl[3 * BM + r]); }
    }
};
template <class Epi, class Sched, bool ALIGN_EPI = false, bool SP2 = false>
__device__ __forceinline__ void gemm_phase(PG8_LAS unsigned char* lds, const Gemm g, const Sched& S, const Epi& E) {
    const int tid = threadIdx.x, wid = __builtin_amdgcn_readfirstlane(tid >> 6), lane = tid & 63, wr = wid >> 2, wc = wid & 3, fr = lane & 15, fq = lane >> 4;
    const int K = g.K, nt = K / BK;
    unsigned voffA[2], voffB[2];
#pragma unroll
    for (int i = 0; i < 2; ++i) { int R, C; stage_rc(tid * 16 + i * 8192, R, C); const int Rb = Epi::PERM ? ((R & ~31) + perm32(R & 31)) : R;
        voffA[i] = (unsigned)(R * K + C) * 2u; voffB[i] = (unsigned)(Rb * K + C) * 2u; }
    const size_t kstep = (size_t)(BK * 2);
    const size_t hstep = (size_t)HALF * K * 2;
    const size_t tstep = 2 * hstep;
    const unsigned ldsw = (unsigned)wid * 1024u;
    const int aoff = lds_byte(wr * 64 + fr, fq * 8), boff = lds_byte(wc * 32 + fr, fq * 8);
#define PG8_SA(b, h) (((b) * 2 + (h)) * HTB)
#define PG8_SB(b, h) ((4 + (b) * 2 + (h)) * HTB)
#define PG8_STAGE(bufoff, gbase, voff) do { _Pragma("unroll") for (int _i = 0; _i < 2; ++_i) \
        __builtin_amdgcn_global_load_lds((const unsigned*)((const char*)(gbase) + (voff)[_i]), (PG8_LAS unsigned*)(lds + (bufoff) + ldsw + _i * 8192), 16, 0, 0); } while (0)
#define PG8_LDA(dst, b, h) do { _Pragma("unroll") for (int m = 0; m < 4; ++m) _Pragma("unroll") for (int k = 0; k < 2; ++k) dst[m][k] = *(const PG8_LAS bf16x8*)(lds + PG8_SA(b, h) + aoff + m * 2048 + k * 1024); } while (0)
#define PG8_LDB(dst, b, h) do { _Pragma("unroll") for (int n = 0; n < 2; ++n) _Pragma("unroll") for (int k = 0; k < 2; ++k) dst[n][k] = *(const PG8_LAS bf16x8*)(lds + PG8_SB(b, h) + boff + n * 2048 + k * 1024); } while (0)
#define PG8_MMA(ai, bj, At, Bt) do { __builtin_amdgcn_s_setprio(1); _Pragma("unroll") for (int m = 0; m < 4; ++m) _Pragma("unroll") for (int n = 0; n < 2; ++n) _Pragma("unroll") for (int k = 0; k < 2; ++k) \
        acc[ai][bj][m][n] = __builtin_amdgcn_mfma_f32_16x16x32_bf16(Bt[n][k], At[m][k], acc[ai][bj][m][n], 0, 0, 0); __builtin_amdgcn_s_setprio(0); } while (0)
#define PG8_WAIT_V(n) asm volatile("s_waitcnt vmcnt(" #n ")" ::: "memory")
#define PG8_WAIT_L(n) asm volatile("s_waitcnt lgkmcnt(" #n ")" ::: "memory")
#define PG8_BAR __builtin_amdgcn_s_barrier()
#define PG8_SCHED __builtin_amdgcn_sched_barrier(0)
    Unit cur, nxt; int ui = 0;
    if (!S.next(0, cur)) return;
    f32x4 acc[2][2][4][2];
#pragma unroll
    for (int a = 0; a < 2; ++a)
#pragma unroll
        for (int b = 0; b < 2; ++b)
#pragma unroll
            for (int m = 0; m < 4; ++m)
#pragma unroll
                for (int n = 0; n < 2; ++n) acc[a][b][m][n] = (f32x4){0.f, 0.f, 0.f, 0.f};
    bf16x8 At[4][2], B0[2][2], B1[2][2];
    const char* cA = (const char*)g.A + (size_t)cur.pm * tstep; const char* cB = (const char*)g.Bt + (size_t)cur.pn * tstep;
    S.a_ready(cur);
    if constexpr (SP2) {
        PG8_STAGE(PG8_SB(0, 0), cB, voffB); PG8_STAGE(PG8_SB(0, 1), cB + hstep, voffB); PG8_STAGE(PG8_SA(0, 0), cA, voffA); PG8_STAGE(PG8_SA(0, 1), cA + hstep, voffA);
        if (wr == 1) PG8_BAR;
        PG8_WAIT_V(2); PG8_BAR;
        PG8_STAGE(PG8_SB(1, 0), cB + kstep, voffB); PG8_STAGE(PG8_SA(1, 0), cA + kstep, voffA); PG8_STAGE(PG8_SB(1, 1), cB + hstep + kstep, voffB);
        PG8_WAIT_V(6); PG8_BAR;
    } else {
        PG8_STAGE(PG8_SB(0, 0), cB, voffB); PG8_STAGE(PG8_SA(0, 0), cA, voffA); PG8_STAGE(PG8_SB(0, 1), cB + hstep, voffB); PG8_STAGE(PG8_SA(0, 1), cA + hstep, voffA);
        if (wr == 1) PG8_BAR;
        PG8_WAIT_V(4); PG8_BAR;
        PG8_STAGE(PG8_SB(1, 0), cB + kstep, voffB); PG8_STAGE(PG8_SA(1, 0), cA + kstep, voffA); PG8_STAGE(PG8_SB(1, 1), cB + hstep + kstep, voffB);
        PG8_WAIT_V(6); PG8_BAR;
    }
    for (;;) {
        const bool has_next = S.next(ui + 1, nxt);
        const char* nA = has_next ? (const char*)g.A + (size_t)nxt.pm * tstep : cA; const char* nB = has_next ? (const char*)g.Bt + (size_t)nxt.pn * tstep : cB;
        for (int t = 0; t < nt; t += 2) {
            const bool last = (t == nt - 2);
            const char* a1 = cA + (size_t)(t + 1) * kstep;
            const char* a2 = last ? nA : cA + (size_t)(t + 2) * kstep; const char* b2 = last ? nB : cB + (size_t)(t + 2) * kstep;
            const char* a3 = a2 + kstep; const char* b3 = b2 + kstep;
            if (last && has_next) S.a_ready(nxt);
            if constexpr (SP2) {
            PG8_LDB(B0, 0, 0); PG8_LDB(B1, 0, 1); PG8_SCHED; PG8_LDA(At, 0, 0); PG8_STAGE(PG8_SA(1, 1), a1 + hstep, voffA);
            PG8_WAIT_V(8); PG8_WAIT_L(0); PG8_BAR; PG8_MMA(0, 0, At, B0); PG8_MMA(0, 1, At, B1); PG8_BAR; PG8_SCHED;
            PG8_LDA(At, 0, 1); PG8_STAGE(PG8_SB(0, 0), b2, voffB); PG8_STAGE(PG8_SB(0, 1), b2 + hstep, voffB); PG8_STAGE(PG8_SA(0, 0), a2, voffA);
            PG8_WAIT_V(8); PG8_WAIT_L(0); PG8_BAR; PG8_MMA(1, 0, At, B0); PG8_MMA(1, 1, At, B1); PG8_BAR; PG8_SCHED;
            PG8_LDB(B0, 1, 0); PG8_LDB(B1, 1, 1); PG8_SCHED; PG8_LDA(At, 1, 0); PG8_STAGE(PG8_SA(0, 1), a2 + hstep, voffA);
            PG8_WAIT_V(8); PG8_WAIT_L(0); PG8_BAR; PG8_MMA(0, 0, At, B0); PG8_MMA(0, 1, At, B1); PG8_BAR; PG8_SCHED;
            PG8_LDA(At, 1, 1); PG8_STAGE(PG8_SB(1, 0), b3, voffB); PG8_STAGE(PG8_SB(1, 1), b3 + hstep, voffB); PG8_STAGE(PG8_SA(1, 0), a3, voffA);
            PG8_WAIT_V(8); PG8_WAIT_L(0); PG8_BAR; PG8_MMA(1, 0, At, B0); PG8_MMA(1, 1, At, B1); PG8_BAR; PG8_SCHED;
            } else {
            PG8_LDB(B0, 0, 0); PG8_SCHED; PG8_LDA(At, 0, 0); PG8_STAGE(PG8_SA(1, 1), a1 + hstep, voffA);
            PG8_WAIT_L(8); PG8_BAR; PG8_WAIT_L(0); PG8_MMA(0, 0, At, B0); PG8_BAR; PG8_SCHED;
            PG8_LDB(B1, 0, 1); PG8_STAGE(PG8_SB(0, 0), b2, voffB);
            PG8_BAR; PG8_WAIT_L(0); PG8_MMA(0, 1, At, B1); PG8_BAR;
            PG8_LDA(At, 0, 1); PG8_STAGE(PG8_SA(0, 0), a2, voffA);
            PG8_BAR; PG8_WAIT_L(0); PG8_MMA(1, 0, At, B0); PG8_BAR; PG8_SCHED;
            PG8_STAGE(PG8_SB(0, 1), b2 + hstep, voffB);
            PG8_WAIT_V(6); PG8_BAR; PG8_MMA(1, 1, At, B1); PG8_BAR;
            PG8_LDB(B0, 1, 0); PG8_SCHED; PG8_LDA(At, 1, 0); PG8_STAGE(PG8_SA(0, 1), a2 + hstep, voffA);
            PG8_WAIT_L(8); PG8_BAR; PG8_WAIT_L(0); PG8_MMA(0, 0, At, B0); PG8_BAR; PG8_SCHED;
            PG8_LDB(B1, 1, 1); PG8_STAGE(PG8_SB(1, 0), b3, voffB);
            PG8_BAR; PG8_WAIT_L(0); PG8_MMA(0, 1, At, B1); PG8_BAR;
            PG8_LDA(At, 1, 1); PG8_STAGE(PG8_SA(1, 0), a3, voffA);
            PG8_BAR; PG8_WAIT_L(0); PG8_MMA(1, 0, At, B0); PG8_BAR; PG8_SCHED;
            PG8_STAGE(PG8_SB(1, 1), b3 + hstep, voffB);
            PG8_WAIT_V(6); PG8_BAR; PG8_MMA(1, 1, At, B1); PG8_BAR;
            }
        }
        if constexpr (ALIGN_EPI) { if (wr == 0) PG8_BAR; }
        if constexpr (!Epi::AFTER_DRAIN) { E(acc, cur, ui, wr, wc, fr, fq); S.done(cur); }
        if (!has_next) break;
#pragma unroll
        for (int a = 0; a < 2; ++a)
#pragma unroll
            for (int b = 0; b < 2; ++b)
#pragma unroll
                for (int m = 0; m < 4; ++m)
#pragma unroll
                    for (int n = 0; n < 2; ++n) acc[a][b][m][n] = (f32x4){0.f, 0.f, 0.f, 0.f};
        cur = nxt; cA = nA; cB = nB; ++ui;
        if constexpr (ALIGN_EPI) { if (wr == 1) PG8_BAR; }
    }
    PG8_WAIT_V(0);
    if constexpr (!ALIGN_EPI) { if (wr == 0) PG8_BAR; }
    PG8_BAR;
    if constexpr (Epi::AFTER_DRAIN) { E.fused(acc, cur, wr, wc, fr, fq, lds, wid, lane); S.done(cur); }
#undef PG8_SA
#undef PG8_SB
#undef PG8_STAGE
#undef PG8_LDA
#undef PG8_LDB
#undef PG8_MMA
#undef PG8_WAIT_V
#undef PG8_WAIT_L
#undef PG8_BAR
#undef PG8_SCHED
}
}

constexpr int NWAVES = 8, NTHR = NWAVES * 64;
constexpr int BATCH = 8, SEQ = 4096, D = 1024, FF = 2816, M = BATCH * SEQ;
constexpr int KCONF = 31;
constexpr float RMS_EPS = 1e-6f, LN_EPS = 1e-5f;
constexpr int NPHASE = 12;
constexpr size_t MiB = 1u << 20;
constexpr size_t WS_STATS = 1 * MiB;
constexpr size_t WS_WIN = 4 * MiB, WS_WOUT = 10 * MiB, WS_PW1 = 12 * MiB, WS_PW2 = 16 * MiB;
constexpr size_t WS_WGU0 = 18 * MiB, WS_WGU1 = 29 * MiB, WS_WDN0 = 40 * MiB, WS_WDN1 = 46 * MiB;
constexpr size_t WS_XB = 64 * MiB;
constexpr size_t WS_BG = 128 * MiB, WS_CV = 192 * MiB, WS_Y = 256 * MiB;
constexpr size_t WS_GU = 320 * MiB;
constexpr size_t WS_END = 496 * MiB;
static_assert(WS_WDN1 + (size_t)D * FF * 2 <= WS_XB && WS_WGU0 + (size_t)2 * FF * D * 2 <= WS_WGU1 && WS_WDN0 + (size_t)D * FF * 2 <= WS_WDN1 && WS_GU + (size_t)M * FF * 2 <= WS_END, "d_ws map");
constexpr int RING_BYTES = 131072;
constexpr int RSL_OFF = RING_BYTES + 4096;
constexpr int LDS_BYTES = 147456;

#define GAS __attribute__((address_space(1)))
#define LAS __attribute__((address_space(3)))
typedef unsigned short bf16;
typedef unsigned v4u __attribute__((ext_vector_type(4)));
typedef unsigned v2u __attribute__((ext_vector_type(2)));
typedef float f32x4 __attribute__((ext_vector_type(4)));
typedef float f32x2 __attribute__((ext_vector_type(2)));
#define LDS_WAIT() asm volatile("s_waitcnt lgkmcnt(0)" ::: "memory")
__device__ __forceinline__ unsigned f2bf(float f) { unsigned u = __builtin_bit_cast(unsigned, f); return (u + 0x7fffu + ((u >> 16) & 1u)) >> 16; }
__device__ __forceinline__ unsigned pk2(float lo, float hi) { return pg8::cvt_pk_bf16(lo, hi); }
__device__ __forceinline__ float bf_lo(unsigned u) { return __builtin_bit_cast(float, u << 16); }
__device__ __forceinline__ float bf_hi(unsigned u) { return __builtin_bit_cast(float, u & 0xffff0000u); }
template <int CTRL> __device__ __forceinline__ float dpp_mov(float v) { return __builtin_bit_cast(float, __builtin_amdgcn_update_dpp(0, __builtin_bit_cast(int, v), CTRL, 0xF, 0xF, false)); }
__device__ __forceinline__ float wave_sum(float v) {
    v += dpp_mov<0xB1>(v); v += dpp_mov<0x4E>(v); v += dpp_mov<0x124>(v); v += dpp_mov<0x128>(v);
    const int iv = __builtin_bit_cast(int, v);
    const float a = __builtin_bit_cast(float, __builtin_amdgcn_readlane(iv, 0)), b = __builtin_bit_cast(float, __builtin_amdgcn_readlane(iv, 16));
    const float c = __builtin_bit_cast(float, __builtin_amdgcn_readlane(iv, 32)), d = __builtin_bit_cast(float, __builtin_amdgcn_readlane(iv, 48));
    return (a + b) + (c + d);
}
__device__ __forceinline__ float sigm(float x) { return __builtin_amdgcn_rcpf(1.0f + __builtin_amdgcn_exp2f(-1.4426950408889634f * x)); }

#define XB_TMO      128
#define XB_XCNT(j)  (256  + 64 * (j))
#define XB_XSUB(j)  (1280 + 64 * (j))
#define XB_XGEN(j)  (2304 + 64 * (j))
#define XB_TOP      3328
#define XB_TOPGEN   3392
#define XCD_BAR_WORDS 3456
#define XB_SPIN_CAP (1u << 18)

__device__ __forceinline__ unsigned xb_ld(unsigned* p)              { return __hip_atomic_load(p, __ATOMIC_RELAXED, __HIP_MEMORY_SCOPE_AGENT); }
__device__ __forceinline__ unsigned xb_add(unsigned* p, unsigned v) { return __hip_atomic_fetch_add(p, v, __ATOMIC_RELAXED, __HIP_MEMORY_SCOPE_AGENT); }
__device__ __forceinline__ unsigned xb_xcc_id() { return (unsigned)__builtin_amdgcn_s_getreg((3 << 11) | 20) & 0xFu; }
#define XB_SPIN(cond, bar) do { unsigned _sp = 0; while (cond) { __builtin_amdgcn_s_sleep(1); \
    if ((++_sp & 255u) == 0u) { if (xb_ld(&(bar)[XB_TMO])) break; if (_sp > XB_SPIN_CAP) { atomicAdd(&(bar)[XB_TMO], 1u); break; } } } } while (0)

struct XcdBarrier {
    unsigned* bar; unsigned x;
    volatile LAS unsigned* st;
};

__device__ __forceinline__ XcdBarrier xcd_barrier_post(unsigned* bar, volatile LAS unsigned* st) {
    XcdBarrier b; b.bar = bar; b.x = xb_xcc_id(); b.st = st;
    if (threadIdx.x == 0) (void)xb_add(&bar[XB_XCNT(b.x)], 1u);
    return b;
}
__device__ __forceinline__ void xcd_barrier_complete(unsigned* bar, unsigned x, unsigned& nloc, unsigned& nx) {
    const unsigned G = gridDim.x * gridDim.y * gridDim.z;
    unsigned sum, cnt, mine, sp = 0u;
    for (;;) {
        sum = 0u; cnt = 0u; mine = 0u;
#pragma unroll
        for (unsigned j = 0; j < 16; ++j) { const unsigned c = xb_ld(&bar[XB_XCNT(j)]); sum += c; cnt += (c > 0u) ? 1u : 0u; mine = (j == x) ? c : mine; }
        if (sum == G) break;
        __builtin_amdgcn_s_sleep(1);
        if ((++sp & 255u) == 0u) { if (xb_ld(&bar[XB_TMO])) break; if (sp > XB_SPIN_CAP) { atomicAdd(&bar[XB_TMO], 1u); break; } }
    }
    nloc = mine > 0u ? mine : 1u; nx = cnt > 0u ? cnt : 1u;
}

__device__ __forceinline__ void xcd_barrier(const XcdBarrier& b, bool local) {
    asm volatile("s_waitcnt vmcnt(0)" ::: "memory");
    __syncthreads();
    if (threadIdx.x == 0) {
        unsigned* bar = b.bar;
        __builtin_amdgcn_s_waitcnt(0);
        unsigned nloc = b.st[0], nx = b.st[1];
        if (nloc == 0u) { xcd_barrier_complete(bar, b.x, nloc, nx); b.st[0] = nloc; b.st[1] = nx; }
        const unsigned old = xb_add(&bar[XB_XSUB(b.x)], 1u);
        const unsigned gen = old / nloc;
        if (old + 1u == (gen + 1u) * nloc) {
          if (!local) {
            __builtin_amdgcn_fence(__ATOMIC_RELEASE, "agent");
            asm volatile("s_waitcnt vmcnt(0)" ::: "memory");
            const unsigned og = xb_add(&bar[XB_TOP], 1u);
            const unsigned tg = og / nx;
            if (og + 1u == (tg + 1u) * nx) xb_add(&bar[XB_TOPGEN], 1u);
            else XB_SPIN(xb_ld(&bar[XB_TOPGEN]) == tg, bar);
          }
            __builtin_amdgcn_fence(__ATOMIC_ACQUIRE, "agent");
            xb_add(&bar[XB_XGEN(b.x)], 1u);
            asm volatile("s_waitcnt vmcnt(0)" ::: "memory");
        } else {
            XB_SPIN(xb_ld(&bar[XB_XGEN(b.x)]) == gen, bar);
            __builtin_amdgcn_fence(__ATOMIC_ACQUIRE, "agent");
            asm volatile("s_waitcnt vmcnt(0)" ::: "memory");
        }
    }
    __syncthreads();
}

__device__ __forceinline__ void p0_transpose_item(const float* W, int K, int N, const float* gain, bf16* WT, int kb, int n0, int drow0, LAS float* scr, int lane) {
    const int k0 = 64 * kb;
#pragma unroll 8
    for (int i = 0; i < 32; ++i) { const int kk = 2 * i + (lane >> 5); scr[kk * 33 + (lane & 31)] = __builtin_nontemporal_load(W + (size_t)(k0 + kk) * N + n0 + (lane & 31)); }
    LDS_WAIT(); asm volatile("" ::: "memory");
    const int c = lane & 7;
    float gk[8];
#pragma unroll
    for (int e = 0; e < 8; ++e) gk[e] = gain ? gain[k0 + 8 * c + e] : 1.0f;
#pragma unroll
    for (int j = 0; j < 4; ++j) { const int n = (lane >> 3) + 8 * j; const LAS float* s = scr + (8 * c) * 33 + n;
        v4u o; o.x = pk2(s[0 * 33] * gk[0], s[1 * 33] * gk[1]); o.y = pk2(s[2 * 33] * gk[2], s[3 * 33] * gk[3]); o.z = pk2(s[4 * 33] * gk[4], s[5 * 33] * gk[5]); o.w = pk2(s[6 * 33] * gk[6], s[7 * 33] * gk[7]);
        __builtin_nontemporal_store(o, (GAS v4u*)(WT + (size_t)(drow0 + n) * K + k0 + 8 * c)); }
    LDS_WAIT(); asm volatile("" ::: "memory");
}
__device__ __forceinline__ int inter128(int j, int h) { return 256 * (j >> 7) + 128 * h + (j & 127); }

#define FILL_RSL(S) do { LAS float* rsl_ = (LAS float*)(lds + RSL_OFF); f32x4 t_[6]; \
        _Pragma("unroll") for (int j_ = 0; j_ < 6; ++j_) { pg8::Unit u_; t_[j_] = (f32x4){1.f, 1.f, 1.f, 1.f};        \
            if (S.next((tid >> 8) + 2 * j_, u_)) t_[j_] = *(const f32x4*)(STATS + (size_t)(u_.pm * 256 + (tid & 255)) * pg8::NSTAT); } \
        _Pragma("unroll") for (int j_ = 0; j_ < 6; ++j_) rsl_[((tid >> 8) + 2 * j_) * 256 + (tid & 255)] = 1.0f / sqrtf(((t_[j_][0] + t_[j_][1]) + (t_[j_][2] + t_[j_][3])) * (1.0f / D) + RMS_EPS); \
        __syncthreads(); } while (0)
struct Args { const float* in[19]; float* out; unsigned char* ws; int ph_lo, ph_hi; };

__global__ void __launch_bounds__(NTHR, 2) trunk_fwd(Args args) {
    extern __shared__ __attribute__((aligned(16))) unsigned char lds_raw[];
    LAS unsigned char* lds = (LAS unsigned char*)lds_raw;
    const int tid = threadIdx.x, lane = tid & 63, wave = __builtin_amdgcn_readfirstlane(tid >> 6);
    const int G = gridDim.x, bid = blockIdx.x;
    unsigned char* ws = args.ws;
    const float* x = args.in[0];
    const float *a_norm = args.in[1], *a_w_in = args.in[2], *a_conv = args.in[3], *a_w_out = args.in[4];
    const float *b_norm = args.in[5], *b_w_pw1 = args.in[6], *b_b_pw1 = args.in[7], *b_conv = args.in[8], *b_b_conv = args.in[9], *b_ln_g = args.in[10], *b_ln_b = args.in[11], *b_w_pw2 = args.in[12], *b_b_pw2 = args.in[13];
    const float *ffn_norm = args.in[14], *ffn_w_gate = args.in[15], *ffn_w_up = args.in[16], *ffn_w_down = args.in[17], *final_norm = args.in[18];
    float* out = args.out;
    float* STATS = (float*)(ws + WS_STATS);
    bf16 *Win_t = (bf16*)(ws + WS_WIN), *Wout_t = (bf16*)(ws + WS_WOUT), *Wpw1_t = (bf16*)(ws + WS_PW1), *Wpw2_t = (bf16*)(ws + WS_PW2);
    bf16 *XB = (bf16*)(ws + WS_XB), *BG = (bf16*)(ws + WS_BG), *CV = (bf16*)(ws + WS_CV), *Y = (bf16*)(ws + WS_Y), *GU = (bf16*)(ws + WS_GU);
    const int lo = args.ph_lo, hi = args.ph_hi;
#if !MK_PER_PHASE
    volatile LAS unsigned* bst = (volatile LAS unsigned*)(lds + RING_BYTES);
    if (tid < 4) bst[tid] = 0u;
    __syncthreads();
    XcdBarrier bar; bar.bar = (unsigned*)ws; bar.x = xb_xcc_id(); bar.st = bst;
    if (tid == 0) bst[2] = xb_add(&bar.bar[XB_XCNT(bar.x)], 1u);
    if (lo < 0) cg::this_grid().sync();
#endif
#define IN(k) (lo <= (k) && (k) < hi)
#if MK_PER_PHASE
#define XLOCAL() false
#define VBLK() bid
#define CVID() bid
#else
#define XLOCAL() ((__builtin_amdgcn_readfirstlane(bst[3]) >> 16) != 0)
#define VBLK() ((int)((__builtin_amdgcn_readfirstlane(bst[3]) >> 16) ? (__builtin_amdgcn_readfirstlane(bst[3]) & 0xffffu) : (unsigned)bid))
#define CVID() ((int)((__builtin_amdgcn_readfirstlane(bst[3]) >> 16) ? ((__builtin_amdgcn_readfirstlane(bst[3]) & 31u) * 8u + ((__builtin_amdgcn_readfirstlane(bst[3]) & 0xffffu) >> 5)) : (unsigned)bid))
#endif
#if MK_PER_PHASE
#define SEAM(k) do { } while (0)
#else
#define SEAM(k) do { if (IN(k) && IN((k) + 1)) { xcd_barrier(bar, XLOCAL()); } } while (0)
#endif

    if (IN(0)) {
        LAS float* scr = (LAS float*)(lds + wave * 16384);
        const int gw = bid * NWAVES + wave, NGW = G * NWAVES;
        constexpr int I_IN = 16 * 96, I_SQ = 16 * 32, I_PW1 = 16 * 64, I_GU = 16 * 88, I_DN = 44 * 32;
        constexpr int NITEMS = I_IN + 2 * I_SQ + I_PW1 + 4 * I_GU + 2 * I_DN;
        for (int it = gw; it < NITEMS; it += NGW) {
            int r = it;
            if (r < I_IN) { const int kb = r / 96, n0 = 32 * (r % 96); const int dr = n0 < 1024 ? 2048 + n0 : (n0 < 2048 ? inter128(n0 - 1024, 0) : inter128(n0 - 2048, 1));
                p0_transpose_item(a_w_in, D, 3 * D, a_norm, Win_t, kb, n0, dr, scr, lane); continue; } r -= I_IN;
            if (r < I_SQ) { const int kb = r / 32, n0 = 32 * (r % 32); p0_transpose_item(a_w_out, D, D, nullptr, Wout_t, kb, n0, n0, scr, lane); continue; } r -= I_SQ;
            if (r < I_SQ) { const int kb = r / 32, n0 = 32 * (r % 32); p0_transpose_item(b_w_pw2, D, D, nullptr, Wpw2_t, kb, n0, n0, scr, lane); continue; } r -= I_SQ;
            if (r < I_PW1) { const int kb = r / 64, n0 = 32 * (r % 64); const int dr = n0 < 1024 ? inter128(n0, 0) : inter128(n0 - 1024, 1);
                p0_transpose_item(b_w_pw1, D, 2 * D, b_norm, Wpw1_t, kb, n0, dr, scr, lane); continue; } r -= I_PW1;
            if (r < 4 * I_GU) { const int q = r / I_GU, rr = r % I_GU, layer = q >> 1, hsel = q & 1; const int kb = rr / 88, n0 = 32 * (rr % 88);
                const float* W = (hsel ? ffn_w_up : ffn_w_gate) + (size_t)layer * D * FF; bf16* WT = (bf16*)(ws + (layer ? WS_WGU1 : WS_WGU0));
                p0_transpose_item(W, D, FF, ffn_norm + layer * D, WT, kb, n0, inter128(n0, hsel), scr, lane); continue; } r -= 4 * I_GU;
            { const int layer = r / I_DN, rr = r % I_DN; const int kb = rr / 32, n0 = 32 * (rr % 32);
                p0_transpose_item(ffn_w_down + (size_t)layer * FF * D, FF, D, nullptr, (bf16*)(ws + (layer ? WS_WDN1 : WS_WDN0)), kb, n0, n0, scr, lane); }
        }
        for (int m = gw; m < M; m += NGW) {
            const GAS f32x4* xr = (const GAS f32x4*)(x + (size_t)m * D) + lane; f32x4 v[4]; float s = 0.f;
#pragma unroll
            for (int j = 0; j < 4; ++j) { v[j] = __builtin_nontemporal_load(xr + 64 * j); s += (v[j].x * v[j].x + v[j].y * v[j].y) + (v[j].z * v[j].z + v[j].w * v[j].w); }
            s = wave_sum(s);
            GAS v2u* o8 = (GAS v2u*)(XB + (size_t)m * D) + lane;
#pragma unroll
            for (int j = 0; j < 4; ++j) { v2u o; o.x = pk2(v[j].x, v[j].y); o.y = pk2(v[j].z, v[j].w); __builtin_nontemporal_store(o, o8 + 64 * j); }
            if (lane == 0) *(GAS f32x4*)(STATS + (size_t)m * pg8::NSTAT) = (f32x4){s, 0.f, 0.f, 0.f};
        }
    }
    SEAM(0);
#if !MK_PER_PHASE
    if (IN(0) && IN(1)) {
        if (tid == 0) { unsigned ok = (G == 256) ? 1u : 0u, npop = 0u, xi = 0u;
            for (unsigned j = 0; j < 16; ++j) { const unsigned c = xb_ld(&bar.bar[XB_XCNT(j)]); if (c) { ok &= (c == 32u) ? 1u : 0u; ++npop; if (j < bar.x) ++xi; } }
            ok &= (npop == 8u) ? 1u : 0u;
            bst[3] = ok ? (0x10000u | (xi * 32u + bst[2])) : 0u; }
        __syncthreads();
    }
#endif
    if (IN(1)) {
        pg8::Gemm g{XB, Win_t, M, 3 * D, D}; pg8::StaticOrder S; S.init(M, 3 * D, G, CVID());
        FILL_RSL(S); pg8::EpiPair<2> E{CV, D, BG, (const LAS float*)(lds + RSL_OFF), nullptr};
        pg8::gemm_phase<pg8::EpiPair<2>, pg8::StaticOrder, true, true>(lds, g, S, E);
    }
    SEAM(1);
    if (IN(2)) {
        const int cg8 = tid & 127, sub = tid >> 7;
        float w0[8], w1[8], w2[8];
#pragma unroll
        for (int e = 0; e < 8; ++e) { w0[e] = a_conv[8 * cg8 + e]; w1[e] = a_conv[D + 8 * cg8 + e]; w2[e] = a_conv[2 * D + 8 * cg8 + e]; }
        constexpr int CH = 32;
        for (int chunk = VBLK() * 4 + sub; chunk < M / CH; chunk += G * 4) {
            const int t0 = chunk * CH; const bool first = (t0 & (SEQ - 1)) == 0;
            const GAS v4u* cvp = (const GAS v4u*)(CV + (size_t)t0 * D + 8 * cg8); const GAS v4u* bgp = (const GAS v4u*)(BG + (size_t)t0 * D + 8 * cg8); GAS v4u* yp = (GAS v4u*)(Y + (size_t)t0 * D + 8 * cg8);
            float p2[8], p1[8];
            { v4u a = (v4u){0u, 0u, 0u, 0u}, b = a; if (!first) { a = cvp[-2 * (D / 8)]; b = cvp[-1 * (D / 8)]; }
#pragma unroll
              for (int e = 0; e < 4; ++e) { p2[2 * e] = bf_lo(a[e]); p2[2 * e + 1] = bf_hi(a[e]); p1[2 * e] = bf_lo(b[e]); p1[2 * e + 1] = bf_hi(b[e]); } }
#pragma unroll 8
            for (int t = 0; t < CH; ++t) {
                const v4u c = __builtin_nontemporal_load(cvp + t * (D / 8)), bgv = __builtin_nontemporal_load(bgp + t * (D / 8)); float cur[8], o[8];
#pragma unroll
                for (int e = 0; e < 4; ++e) { cur[2 * e] = bf_lo(c[e]); cur[2 * e + 1] = bf_hi(c[e]); }
#pragma unroll
                for (int e = 0; e < 4; ++e) { o[2 * e] = bf_lo(bgv[e]) * (w0[2 * e] * p2[2 * e] + w1[2 * e] * p1[2 * e] + w2[2 * e] * cur[2 * e]);
                                              o[2 * e + 1] = bf_hi(bgv[e]) * (w0[2 * e + 1] * p2[2 * e + 1] + w1[2 * e + 1] * p1[2 * e + 1] + w2[2 * e + 1] * cur[2 * e + 1]); }
                v4u ov; ov.x = pk2(o[0], o[1]); ov.y = pk2(o[2], o[3]); ov.z = pk2(o[4], o[5]); ov.w = pk2(o[6], o[7]);
                yp[t * (D / 8)] = ov;
#pragma unroll
                for (int e = 0; e < 8; ++e) { p2[e] = p1[e]; p1[e] = cur[e]; }
            }
        }
    }
    SEAM(2);
    if (IN(3)) {
        pg8::Gemm g{Y, Wout_t, M, D, D}; pg8::StaticOrder S; S.init(M, D, G, CVID());
        pg8::EpiRes E{XB, STATS, nullptr, (LAS float*)(lds + RSL_OFF)};
        pg8::gemm_phase<pg8::EpiRes, pg8::StaticOrder, true, true>(lds, g, S, E);
    }
    SEAM(3);
    if (IN(4)) {
        pg8::Gemm g{XB, (const bf16*)(ws + WS_WGU0), M, 2 * FF, D}; pg8::StaticOrder S; S.init(M, 2 * FF, G, CVID());
        FILL_RSL(S); pg8::EpiPair<0> E{GU, FF, nullptr, (const LAS float*)(lds + RSL_OFF), nullptr};
        pg8::gemm_phase<pg8::EpiPair<0>, pg8::StaticOrder, true, true>(lds, g, S, E);
    }
    SEAM(4);
    if (IN(5)) {
        pg8::Gemm g{GU, (const bf16*)(ws + WS_WDN0), M, D, FF}; pg8::StaticOrder S; S.init(M, D, G, CVID());
        pg8::EpiRes E{XB, STATS, nullptr, (LAS float*)(lds + RSL_OFF)};
        pg8::gemm_phase<pg8::EpiRes, pg8::StaticOrder, true, true>(lds, g, S, E);
    }
    SEAM(5);
    if (IN(6)) {
        pg8::Gemm g{XB, Wpw1_t, M, 2 * D, D}; pg8::StaticOrder S; S.init(M, 2 * D, G, CVID());
        FILL_RSL(S); pg8::EpiPair<1> E{BG, D, nullptr, (const LAS float*)(lds + RSL_OFF), b_b_pw1};
        pg8::gemm_phase<pg8::EpiPair<1>, pg8::StaticOrder, true, true>(lds, g, S, E);
    }
    SEAM(6);
    if (IN(7)) {
        const int c0 = 2 * tid;
        f32x2 w[KCONF];
#pragma unroll
        for (int k = 0; k < KCONF; ++k) w[k] = *(const f32x2*)(b_conv + k * D + c0);
        const f32x2 cb = *(const f32x2*)(b_b_conv + c0);
        f32x4 lng4[4], lnb4[4];
#pragma unroll
        for (int j = 0; j < 4; ++j) { lng4[j] = *(const f32x4*)(b_ln_g + 4 * lane + 256 * j); lnb4[j] = *(const f32x4*)(b_ln_b + 4 * lane + 256 * j); }
        constexpr int TT = 16, NTILE = M / TT; const int per = (NTILE + G - 1) / G, tb = VBLK() * per, te = (tb + per < NTILE) ? tb + per : NTILE, nt_ = te - tb;
        unsigned xr[30 + TT];
        if (nt_ > 0) { const int t0 = tb * TT; const bool first = (t0 & (SEQ - 1)) == 0; const GAS unsigned* src = (const GAS unsigned*)(BG + (size_t)t0 * D + c0);
#pragma unroll
            for (int s = 0; s < 30 + TT; ++s) { const bool pad = first && s < 30; const unsigned u = src[(long)(pad ? 0 : s - 30) * (D / 2)]; xr[s] = pad ? 0u : u; } }
#define P7_CONV(i_) do { f32x2 acc[TT]; \
            _Pragma("unroll") for (int t = 0; t < TT; ++t) acc[t] = cb; \
            _Pragma("unroll") for (int s = 0; s < 30 + TT; ++s) { const f32x2 xv = (f32x2){bf_lo(xr[s]), bf_hi(xr[s])}; \
                _Pragma("unroll") for (int t = (s > 30 ? s - 30 : 0); t <= (s < TT ? s : TT - 1); ++t) acc[t] += w[s - t] * xv; } \
            LAS float* Tw = (LAS float*)(lds + ((i_) & 1) * 65536); \
            _Pragma("unroll") for (int t = 0; t < TT; ++t) *(LAS f32x2*)(Tw + t * D + c0) = acc[t]; } while (0)
#define P7_LN(i_) do { const LAS float* Tr = (const LAS float*)(lds + ((i_) & 1) * 65536); const int tbase = (tb + (i_)) * TT; \
            _Pragma("unroll") for (int q = 0; q < 2; ++q) { const int t = wave * 2 + q; f32x4 v[4]; float s = 0.f, s2 = 0.f; \
                _Pragma("unroll") for (int j = 0; j < 4; ++j) { v[j] = *(const LAS f32x4*)(Tr + t * D + 4 * lane + 256 * j); s += (v[j].x + v[j].y) + (v[j].z + v[j].w); s2 += (v[j].x * v[j].x + v[j].y * v[j].y) + (v[j].z * v[j].z + v[j].w * v[j].w); } \
                const float mean = wave_sum(s) * (1.f / D); const float var = fmaxf(wave_sum(s2) * (1.f / D) - mean * mean, 0.f); \
                const float rstd = 1.f / sqrtf(var + LN_EPS); \
                GAS v2u* o8 = (GAS v2u*)(CV + (size_t)(tbase + t) * D) + lane; \
                _Pragma("unroll") for (int j = 0; j < 4; ++j) { const f32x4 gg = lng4[j], bb = lnb4[j]; \
                    f32x4 y = (v[j] - mean) * rstd * gg + bb; y.x *= sigm(y.x); y.y *= sigm(y.y); y.z *= sigm(y.z); y.w *= sigm(y.w); \
                    v2u o; o.x = pk2(y.x, y.y); o.y = pk2(y.z, y.w); o8[64 * j] = o; } } } while (0)
        for (int i = 0; i <= nt_; ++i) {
            unsigned xn[TT];
            if (i + 1 < nt_) { const GAS unsigned* src = (const GAS unsigned*)(BG + (size_t)((tb + i + 1) * TT) * D + c0);
#pragma unroll
                for (int s = 0; s < TT; ++s) xn[s] = __builtin_nontemporal_load(src + (long)s * (D / 2)); }
            else {
#pragma unroll
                for (int s = 0; s < TT; ++s) xn[s] = 0u; }
            if (i == 0) { P7_CONV(i); }
            else if (i == nt_) { P7_LN(i - 1); }
            else if (wave < 4) { P7_CONV(i); P7_LN(i - 1); }
            else { P7_LN(i - 1); P7_CONV(i); }
            __syncthreads();
            const bool nfirst = (((tb + i + 1) * TT) & (SEQ - 1)) == 0;
#pragma unroll
            for (int s = 0; s < 30; ++s) xr[s] = nfirst ? 0u : xr[s + TT];
#pragma unroll
            for (int s = 0; s < TT; ++s) xr[30 + s] = xn[s];
        }
#undef P7_CONV
#undef P7_LN
    }
    SEAM(7);
    if (IN(8)) {
        pg8::Gemm g{CV, Wpw2_t, M, D, D}; pg8::StaticOrder S; S.init(M, D, G, CVID());
        pg8::EpiRes E{XB, STATS, b_b_pw2, (LAS float*)(lds + RSL_OFF)};
        pg8::gemm_phase<pg8::EpiRes, pg8::StaticOrder, true, true>(lds, g, S, E);
    }
    SEAM(8);
    if (IN(9)) {
        pg8::Gemm g{XB, (const bf16*)(ws + WS_WGU1), M, 2 * FF, D}; pg8::StaticOrder S; S.init(M, 2 * FF, G, CVID());
        FILL_RSL(S); pg8::EpiPair<0> E{GU, FF, nullptr, (const LAS float*)(lds + RSL_OFF), nullptr};
        pg8::gemm_phase<pg8::EpiPair<0>, pg8::StaticOrder, true, true>(lds, g, S, E);
    }
    SEAM(9);
    if (IN(10)) {
        pg8::Gemm g{GU, (const bf16*)(ws + WS_WDN1), M, D, FF}; pg8::StaticOrder S; S.init(M, D, G, CVID());
        pg8::EpiRes E{XB, STATS, nullptr, (LAS float*)(lds + RSL_OFF)};
        pg8::gemm_phase<pg8::EpiRes, pg8::StaticOrder, true, true>(lds, g, S, E);
    }
    SEAM(10);
    if (IN(11)) {
        const int gw = bid * NWAVES + wave, NGW = G * NWAVES;
        f32x4 gn[4];
#pragma unroll
        for (int j = 0; j < 4; ++j) gn[j] = *(const f32x4*)(final_norm + 4 * lane + 256 * j);
        const int vblk11 = VBLK();
        for (int mi = 0; mi < (M / 128 + G - 1) / G * 16; ++mi) { const int blk_ = vblk11 + (mi >> 4) * G; if (blk_ >= M / 128) break; const int m = blk_ * 128 + wave * 16 + (mi & 15);
            const GAS v2u* hr = (const GAS v2u*)(XB + (size_t)m * D) + lane; v2u hv[4];
#pragma unroll
            for (int j = 0; j < 4; ++j) hv[j] = __builtin_nontemporal_load(hr + 64 * j);
            float s = lane < pg8::NSTAT ? STATS[(size_t)m * pg8::NSTAT + lane] : 0.f;
            s += __shfl_xor(s, 1); s += __shfl_xor(s, 2);
            const float r = 1.f / sqrtf(__shfl(s, 0) * (1.f / D) + RMS_EPS);
            GAS f32x4* orow = (GAS f32x4*)(out + (size_t)m * D) + lane;
#pragma unroll
            for (int j = 0; j < 4; ++j) { const f32x4 v = (f32x4){bf_lo(hv[j].x), bf_hi(hv[j].x), bf_lo(hv[j].y), bf_hi(hv[j].y)}; __builtin_nontemporal_store(v * r * gn[j], orow + 64 * j); }
        }
    }
#undef IN
#undef SEAM
}

extern "C" void kernel_launch(void* const* d_in, const int* in_sizes, int n_in, void* d_out, int out_size, void* d_ws, size_t ws_size, hipStream_t stream) {
    static int grid = 0;
    if (grid == 0) {
        if (n_in != 19 || in_sizes[0] != M * D || out_size != M * D || ws_size < WS_END) { fprintf(stderr, "kernel_launch: shape/workspace mismatch: n_in %d in0 %d out %d ws %zu (need %zu); nothing launched\n", n_in, n_in > 0 ? in_sizes[0] : -1, out_size, ws_size, (size_t)WS_END); grid = -1; return; }
        int dev = 0, cus = 0, per_cu = 0;
        if (hipGetDevice(&dev) != hipSuccess || hipDeviceGetAttribute(&cus, hipDeviceAttributeMultiprocessorCount, dev) != hipSuccess) { fprintf(stderr, "kernel_launch: device query failed\n"); grid = -1; return; }
        if (hipFuncSetAttribute((const void*)trunk_fwd, hipFuncAttributeMaxDynamicSharedMemorySize, LDS_BYTES) != hipSuccess) { fprintf(stderr, "kernel_launch: hipFuncSetAttribute failed\n"); grid = -1; return; }
        if (hipOccupancyMaxActiveBlocksPerMultiprocessor(&per_cu, (const void*)trunk_fwd, NTHR, LDS_BYTES) != hipSuccess || per_cu < 1) { fprintf(stderr, "kernel_launch: occupancy query says %d blocks/CU; using 1\n", per_cu); per_cu = 1; }
        (void)hipGetLastError();
        grid = cus * per_cu;
    }
    if (grid < 0) return;
    Args a{};
    for (int i = 0; i < 19; ++i) a.in[i] = (const float*)d_in[i];
    a.out = (float*)d_out; a.ws = (unsigned char*)d_ws;
#if MK_PER_PHASE
    for (int p = 0; p < NPHASE; ++p) { a.ph_lo = p; a.ph_hi = p + 1; hipLaunchKernelGGL(trunk_fwd, dim3(grid), dim3(NTHR), LDS_BYTES, stream, a); }
#else
    a.ph_lo = 0; a.ph_hi = NPHASE;
    if (hipMemsetAsync(d_ws, 0, 16384, stream) != hipSuccess) { fprintf(stderr, "kernel_launch: memset of the barrier words failed\n"); return; }
    void* kargs[] = {&a};
    hipError_t e = hipLaunchCooperativeKernel((const void*)trunk_fwd, dim3(grid), dim3(NTHR), kargs, LDS_BYTES, stream);
    if (e != hipSuccess) fprintf(stderr, "kernel_launch: cooperative launch failed: %s (grid %d)\n", hipGetErrorString(e), grid);
#if MK_PROBE_PHASE >= 0
    a.ph_lo = MK_PROBE_PHASE; a.ph_hi = MK_PROBE_PHASE + 1; hipLaunchKernelGGL(trunk_fwd, dim3(grid), dim3(NTHR), LDS_BYTES, stream, a);
#endif
#endif
}
```

```cpp
#include <hip/hip_runtime.h>
#include <hip/hip_cooperative_groups.h>
#include <cstdio>
#include <cstdint>
namespace cg = cooperative_groups;
#ifndef MK_PROBE_PHASE
#define MK_PROBE_PHASE -1
#endif
#ifndef MK_PER_PHASE
#define MK_PER_PHASE 0
#endif
namespace pg8 {
#define PG8_LAS __attribute__((address_space(3)))
typedef unsigned short bf16_t;
typedef short bf16x8 __attribute__((ext_vector_type(8)));
typedef float f32x4 __attribute__((ext_vector_type(4)));
typedef unsigned u32x4 __attribute__((ext_vector_type(4)));
constexpr int BM = 256, BK = 64, HALF = 128, HTB = HALF * BK * 2  , STAGE_BYTES = 8 * HTB, NXCD = 8, WGM = 4;

__host__ __device__ __forceinline__ int lds_byte(int r, int c) { const int st = (r >> 4) * 2 + (c >> 5), rr = r & 15, cc = c & 31, ob = rr * 64 + cc * 2; return st * 1024 + (ob ^ (((ob >> 9) & 1) << 5)); }
__host__ __device__ __forceinline__ void stage_rc(int b, int& R, int& C) { const int st = b / 1024, sb = b % 1024, swz = sb ^ (((sb >> 9) & 1) << 5); R = (st >> 1) * 16 + swz / 64; C = (st & 1) * 32 + (swz % 64) / 2; }
__host__ __device__ __forceinline__ int perm32(int rho) { const int n = rho >> 4, i = rho & 15; return 8 * (i >> 2) + 4 * n + (i & 3); }

struct Unit { int pm, pn; };
struct Gemm { const bf16_t* A; const bf16_t* Bt; int M, N, K; };

struct StaticOrder {
    int nM, nN, nwg, G, c;
    __host__ __device__ void init(int M, int N, int G_, int c_) { nM = M / BM; nN = N / BM; nwg = nM * nN; G = G_; c = c_; }
    __host__ __device__ bool next(int i, Unit& u) const {
        const long L = (long)i * G + c; if (L >= nwg) return false;
        int wgid = (int)L; { const int q = nwg / NXCD, r = nwg % NXCD, xcd = wgid % NXCD, off = wgid / NXCD; wgid = (xcd < r ? xcd * (q + 1) : r * (q + 1) + (xcd - r) * q) + off; }
        const int nig = WGM * nN, gid = wgid / nig, fm = gid * WGM, gsz = (nM - fm) < WGM ? (nM - fm) : WGM;
        u.pm = fm + ((wgid % nig) % gsz); u.pn = (wgid % nig) / gsz; return true;
    }
    __device__ __forceinline__ void a_ready(const Unit&) const {}
    __device__ __forceinline__ void done(const Unit&) const {}
};

__device__ __forceinline__ unsigned cvt_pk_bf16(float lo, float hi) { unsigned r; asm volatile("v_cvt_pk_bf16_f32 %0, %1, %2" : "=v"(r) : "v"(lo), "v"(hi)); return r; }
typedef float f32x2 __attribute__((ext_vector_type(2)));
__device__ __forceinline__ float sigmoid_f(float x) { return __builtin_amdgcn_rcpf(1.0f + __builtin_amdgcn_exp2f(-1.4426950408889634f * x)); }
constexpr int NSTAT = 4;
__device__ __forceinline__ void load_rscale(const float* stats, int row0, int fq, float (&rs)[2][4]) {
#pragma unroll
    for (int ai = 0; ai < 2; ++ai)
#pragma unroll
        for (int m = 0; m < 4; ++m) {
            const f32x4 p = *(const f32x4*)(stats + (size_t)(row0 + ai * HALF + m * 16) * NSTAT + fq * 4);
            float s = (p[0] + p[1]) + (p[2] + p[3]); s += __shfl_xor(s, 16); s += __shfl_xor(s, 32);
            rs[ai][m] = 1.0f / sqrtf(s * (1.0f / 1024.0f) + 1e-6f);
        }
}
__device__ __forceinline__ u32x4 pack8(const f32x4 v0, const f32x4 v1) { u32x4 w; w.x = cvt_pk_bf16(v0[0], v0[1]); w.y = cvt_pk_bf16(v0[2], v0[3]); w.z = cvt_pk_bf16(v1[0], v1[1]); w.w = cvt_pk_bf16(v1[2], v1[3]); return w; }
template <int MODE> struct EpiPair {
    static constexpr bool PERM = true, AFTER_DRAIN = false;
    bf16_t* O; int ldc; bf16_t* O2; const PG8_LAS float* rsl; const float* bias;
    __device__ __forceinline__ void operator()(const f32x4 (&acc)[2][2][4][2], const Unit& u, int ui, int wr, int wc, int fr, int fq) const {
        const int row0 = u.pm * BM + wr * 64 + fr, cw = wc * 32 + 8 * fq;
        float rs[2][4];
#pragma unroll
        for (int ai = 0; ai < 2; ++ai)
#pragma unroll
            for (int m = 0; m < 4; ++m) rs[ai][m] = rsl[ui * BM + ai * HALF + wr * 64 + m * 16 + fr];
        if (MODE == 2 && u.pn >= 8) {
#pragma unroll
            for (int ai = 0; ai < 2; ++ai)
#pragma unroll
                for (int m = 0; m < 4; ++m) { const float r = rs[ai][m]; bf16_t* rowp = O2 + (size_t)(row0 + ai * HALF + m * 16) * 1024 + (u.pn - 8) * BM + cw;
#pragma unroll
                    for (int bj = 0; bj < 2; ++bj) *(u32x4*)(rowp + bj * HALF) = pack8(acc[ai][bj][m][0] * r, acc[ai][bj][m][1] * r); }
            return;
        }
        f32x4 bp[2], bq[2];
#pragma unroll
        for (int n = 0; n < 2; ++n) { bp[n] = (f32x4){0.f, 0.f, 0.f, 0.f}; bq[n] = bp[n]; if (MODE == 1) { bp[n] = *(const f32x4*)(bias + u.pn * HALF + cw + 4 * n); bq[n] = *(const f32x4*)(bias + 1024 + u.pn * HALF + cw + 4 * n); } }
#pragma unroll
        for (int ai = 0; ai < 2; ++ai)
#pragma unroll
            for (int m = 0; m < 4; ++m) { const float r = rs[ai][m], r2 = r * r, rc = -1.4426950408889634f * r; bf16_t* rowp = O + (size_t)(row0 + ai * HALF + m * 16) * ldc + u.pn * HALF + cw;
                f32x4 o[2];
#pragma unroll
                for (int n = 0; n < 2; ++n) { const f32x4 ap = acc[ai][0][m][n], aq = acc[ai][1][m][n];
                    if (MODE == 0) { const f32x4 t = ap * rc; f32x4 d; d[0] = __builtin_amdgcn_exp2f(t[0]); d[1] = __builtin_amdgcn_exp2f(t[1]); d[2] = __builtin_amdgcn_exp2f(t[2]); d[3] = __builtin_amdgcn_exp2f(t[3]);
                        d = d + 1.0f; f32x4 s; s[0] = __builtin_amdgcn_rcpf(d[0]); s[1] = __builtin_amdgcn_rcpf(d[1]); s[2] = __builtin_amdgcn_rcpf(d[2]); s[3] = __builtin_amdgcn_rcpf(d[3]);
                        o[n] = (ap * aq) * (s * r2); }
                    else if (MODE == 1) { const f32x4 p = ap * r + bp[n], q = aq * r + bq[n], t = q * (-1.4426950408889634f); f32x4 d; d[0] = __builtin_amdgcn_exp2f(t[0]); d[1] = __builtin_amdgcn_exp2f(t[1]); d[2] = __builtin_amdgcn_exp2f(t[2]); d[3] = __builtin_amdgcn_exp2f(t[3]);
                        d = d + 1.0f; f32x4 s; s[0] = __builtin_amdgcn_rcpf(d[0]); s[1] = __builtin_amdgcn_rcpf(d[1]); s[2] = __builtin_amdgcn_rcpf(d[2]); s[3] = __builtin_amdgcn_rcpf(d[3]);
                        o[n] = p * s; }
                    else o[n] = (ap * aq) * r2; }
                if (MODE == 2) *(u32x4*)rowp = pack8(o[0], o[1]); else __builtin_nontemporal_store(pack8(o[0], o[1]), (u32x4*)rowp); }
    }
};
struct EpiRes {
    static constexpr bool PERM = true, AFTER_DRAIN = false;
    bf16_t* xb; float* stats; const float* bias; PG8_LAS float* xl;
    __device__ __forceinline__ void operator()(const f32x4 (&acc)[2][2][4][2], const Unit& u, int ui, int wr, int wc, int fr, int fq) const {
        const int row0 = u.pm * BM + wr * 64 + fr, col0 = u.pn * BM + wc * 32 + 8 * fq;
        u32x4 b[2][2][2];
#define RES_LOAD(g) do { _Pragma("unroll") for (int mm = 0; mm < 2; ++mm) _Pragma("unroll") for (int bj = 0; bj < 2; ++bj) \
            b[(g) & 1][mm][bj] = *(const u32x4*)(xb + (size_t)(row0 + ((g) >> 1) * HALF + (2 * ((g) & 1) + mm) * 16) * 1024 + col0 + bj * HALF); } while (0)
        RES_LOAD(0); RES_LOAD(1);
        asm volatile("" ::: "memory");
#pragma unroll
        for (int g = 0; g < 4; ++g) {
#pragma unroll
            for (int mm = 0; mm < 2; ++mm) { const int ai = g >> 1, m = 2 * (g & 1) + mm; const int row = row0 + ai * HALF + m * 16; bf16_t* p = xb + (size_t)row * 1024 + col0; float ss = 0.f;
#pragma unroll
                for (int bj = 0; bj < 2; ++bj) { const u32x4 bb = b[g & 1][mm][bj];
                    const f32x4 b0 = (f32x4){__builtin_bit_cast(float, bb.x << 16), __builtin_bit_cast(float, bb.x & 0xffff0000u), __builtin_bit_cast(float, bb.y << 16), __builtin_bit_cast(float, bb.y & 0xffff0000u)};
                    const f32x4 b1 = (f32x4){__builtin_bit_cast(float, bb.z << 16), __builtin_bit_cast(float, bb.z & 0xffff0000u), __builtin_bit_cast(float, bb.w << 16), __builtin_bit_cast(float, bb.w & 0xffff0000u)};
                    f32x4 v0 = b0 + acc[ai][bj][m][0], v1 = b1 + acc[ai][bj][m][1];
                    if (bias) { v0 += *(const f32x4*)(bias + col0 + bj * HALF); v1 += *(const f32x4*)(bias + col0 + bj * HALF + 4); }
                    ss += (v0[0] * v0[0] + v0[1] * v0[1]) + (v0[2] * v0[2] + v0[3] * v0[3]) + (v1[0] * v1[0] + v1[1] * v1[1]) + (v1[2] * v1[2] + v1[3] * v1[3]);
                    *(u32x4*)(p + bj * HALF) = pack8(v0, v1); }
                ss += __shfl_xor(ss, 16); ss += __shfl_xor(ss, 32); if (fq == 0) xl[wc * BM + ai * HALF + wr * 64 + m * 16 + fr] = ss; }
            asm volatile("" ::: "memory");
            if (g + 2 < 4) { RES_LOAD(g + 2); asm volatile("" ::: "memory"); }
        }
#undef RES_LOAD
        asm volatile("s_waitcnt lgkmcnt(0)" ::: "memory"); __builtin_amdgcn_s_barrier(); asm volatile("" ::: "memory");
        if (threadIdx.x < 256) { const int r = threadIdx.x; stats[(size_t)(u.pm * BM + r) * NSTAT + u.pn] = (xl[r] + xl[BM + r]) + (xl[2 * BM + r] + xl[3 * BM + r]); }
    }
};
template <class Epi, class Sched, bool ALIGN_EPI = false, bool SP2 = false>
__device__ __forceinline__ void gemm_phase(PG8_LAS unsigned char* lds, const Gemm g, const Sched& S, const Epi& E) {
    const int tid = threadIdx.x, wid = __builtin_amdgcn_readfirstlane(tid >> 6), lane = tid & 63, wr = wid >> 2, wc = wid & 3, fr = lane & 15, fq = lane >> 4;
    const int K = g.K, nt = K / BK;
    unsigned voffA[2], voffB[2];
#pragma unroll
    for (int i = 0; i < 2; ++i) { int R, C; stage_rc(tid * 16 + i * 8192, R, C); const int Rb = Epi::PERM ? ((R & ~31) + perm32(R & 31)) : R;
        voffA[i] = (unsigned)(R * K + C) * 2u; voffB[i] = (unsigned)(Rb * K + C) * 2u; }
    const size_t kstep = (size_t)(BK * 2);
    const size_t hstep = (size_t)HALF * K * 2;
    const size_t tstep = 2 * hstep;
    const unsigned ldsw = (unsigned)wid * 1024u;
    const int aoff = lds_byte(wr * 64 + fr, fq * 8), boff = lds_byte(wc * 32 + fr, fq * 8);
#define PG8_SA(b, h) (((b) * 2 + (h)) * HTB)
#define PG8_SB(b, h) ((4 + (b) * 2 + (h)) * HTB)
#define PG8_STAGE(bufoff, gbase, voff) do { _Pragma("unroll") for (int _i = 0; _i < 2; ++_i) \
        __builtin_amdgcn_global_load_lds((const unsigned*)((const char*)(gbase) + (voff)[_i]), (PG8_LAS unsigned*)(lds + (bufoff) + ldsw + _i * 8192), 16, 0, 0); } while (0)
#define PG8_LDA(dst, b, h) do { _Pragma("unroll") for (int m = 0; m < 4; ++m) _Pragma("unroll") for (int k = 0; k < 2; ++k) dst[m][k] = *(const PG8_LAS bf16x8*)(lds + PG8_SA(b, h) + aoff + m * 2048 + k * 1024); } while (0)
#define PG8_LDB(dst, b, h) do { _Pragma("unroll") for (int n = 0; n < 2; ++n) _Pragma("unroll") for (int k = 0; k < 2; ++k) dst[n][k] = *(const PG8_LAS bf16x8*)(lds + PG8_SB(b, h) + boff + n * 2048 + k * 1024); } while (0)
#define PG8_MMA(ai, bj, At, Bt) do { __builtin_amdgcn_s_setprio(1); _Pragma("unroll") for (int m = 0; m < 4; ++m) _Pragma("unroll") for (int n = 0; n < 2; ++n) _Pragma("unroll") for (int k = 0; k < 2; ++k) \
        acc[ai][bj][m][n] = __builtin_amdgcn_mfma_f32_16x16x32_bf16(Bt[n][k], At[m][k], acc[ai][bj][m][n], 0, 0, 0); __builtin_amdgcn_s_setprio(0); } while (0)
#define PG8_WAIT_V(n) asm volatile("s_waitcnt vmcnt(" #n ")" ::: "memory")
#define PG8_WAIT_L(n) asm volatile("s_waitcnt lgkmcnt(" #n ")" ::: "memory")
#define PG8_BAR __builtin_amdgcn_s_barrier()
#define PG8_SCHED __builtin_amdgcn_sched_barrier(0)
    Unit cur, nxt; int ui = 0;
    if (!S.next(0, cur)) return;
    f32x4 acc[2][2][4][2];
#pragma unroll
    for (int a = 0; a < 2; ++a)
#pragma unroll
        for (int b = 0; b < 2; ++b)
#pragma unroll
            for (int m = 0; m < 4; ++m)
#pragma unroll
                for (int n = 0; n < 2; ++n) acc[a][b][m][n] = (f32x4){0.f, 0.f, 0.f, 0.f};
    bf16x8 At[4][2], B0[2][2], B1[2][2];
    const char* cA = (const char*)g.A + (size_t)cur.pm * tstep; const char* cB = (const char*)g.Bt + (size_t)cur.pn * tstep;
    S.a_ready(cur);
    if constexpr (SP2) {
        PG8_STAGE(PG8_SB(0, 0), cB, voffB); PG8_STAGE(PG8_SB(0, 1), cB + hstep, voffB); PG8_STAGE(PG8_SA(0, 0), cA, voffA); PG8_STAGE(PG8_SA(0, 1), cA + hstep, voffA);
        if (wr == 1) PG8_BAR;
        PG8_WAIT_V(2); PG8_BAR;
        PG8_STAGE(PG8_SB(1, 0), cB + kstep, voffB); PG8_STAGE(PG8_SA(1, 0), cA + kstep, voffA); PG8_STAGE(PG8_SB(1, 1), cB + hstep + kstep, voffB);
        PG8_WAIT_V(6); PG8_BAR;
    } else {
        PG8_STAGE(PG8_SB(0, 0), cB, voffB); PG8_STAGE(PG8_SA(0, 0), cA, voffA); PG8_STAGE(PG8_SB(0, 1), cB + hstep, voffB); PG8_STAGE(PG8_SA(0, 1), cA + hstep, voffA);
        if (wr == 1) PG8_BAR;
        PG8_WAIT_V(4); PG8_BAR;
        PG8_STAGE(PG8_SB(1, 0), cB + kstep, voffB); PG8_STAGE(PG8_SA(1, 0), cA + kstep, voffA); PG8_STAGE(PG8_SB(1, 1), cB + hstep + kstep, voffB);
        PG8_WAIT_V(6); PG8_BAR;
    }
    for (;;) {
        const bool has_next = S.next(ui + 1, nxt);
        const char* nA = has_next ? (const char*)g.A + (size_t)nxt.pm * tstep : cA; const char* nB = has_next ? (const char*)g.Bt + (size_t)nxt.pn * tstep : cB;
        for (int t = 0; t < nt; t += 2) {
            const bool last = (t == nt - 2);
            const char* a1 = cA + (size_t)(t + 1) * kstep;
            const char* a2 = last ? nA : cA + (size_t)(t + 2) * kstep; const char* b2 = last ? nB : cB + (size_t)(t + 2) * kstep;
            const char* a3 = a2 + kstep; const char* b3 = b2 + kstep;
            if (last && has_next) S.a_ready(nxt);
            if constexpr (SP2) {
            PG8_LDB(B0, 0, 0); PG8_LDB(B1, 0, 1); PG8_SCHED; PG8_LDA(At, 0, 0); PG8_STAGE(PG8_SA(1, 1), a1 + hstep, voffA);
            PG8_WAIT_V(8); PG8_WAIT_L(0); PG8_BAR; PG8_MMA(0, 0, At, B0); PG8_MMA(0, 1, At, B1); PG8_BAR; PG8_SCHED;
            PG8_LDA(At, 0, 1); PG8_STAGE(PG8_SB(0, 0), b2, voffB); PG8_STAGE(PG8_SB(0, 1), b2 + hstep, voffB); PG8_STAGE(PG8_SA(0, 0), a2, voffA);
            PG8_WAIT_V(8); PG8_WAIT_L(0); PG8_BAR; PG8_MMA(1, 0, At, B0); PG8_MMA(1, 1, At, B1); PG8_BAR; PG8_SCHED;
            PG8_LDB(B0, 1, 0); PG8_LDB(B1, 1, 1); PG8_SCHED; PG8_LDA(At, 1, 0); PG8_STAGE(PG8_SA(0, 1), a2 + hstep, voffA);
            PG8_WAIT_V(8); PG8_WAIT_L(0); PG8_BAR; PG8_MMA(0, 0, At, B0); PG8_MMA(0, 1, At, B1); PG8_BAR; PG8_SCHED;
            PG8_LDA(At, 1, 1); PG8_STAGE(PG8_SB(1, 0), b3, voffB); PG8_STAGE(PG8_SB(1, 1), b3 + hstep, voffB); PG8_STAGE(PG8_SA(1, 0), a3, voffA);
            PG8_WAIT_V(8); PG8_WAIT_L(0); PG8_BAR; PG8_MMA(1, 0, At, B0); PG8_MMA(1, 1, At, B1); PG8_BAR; PG8_SCHED;
            } else {
            PG8_LDB(B0, 0, 0); PG8_SCHED; PG8_LDA(At, 0, 0); PG8_STAGE(PG8_SA(1, 1), a1 + hstep, voffA);
            PG8_WAIT_L(8); PG8_BAR; PG8_WAIT_L(0); PG8_MMA(0, 0, At, B0); PG8_BAR; PG8_SCHED;
            PG8_LDB(B1, 0, 1); PG8_STAGE(PG8_SB(0, 0), b2, voffB);
            PG8_BAR; PG8_WAIT_L(0); PG8_MMA(0, 1, At, B1); PG8_BAR;
            PG8_LDA(At, 0, 1); PG8_STAGE(PG8_SA(0, 0), a2, voffA);
            PG8_BAR; PG8_WAIT_L(0); PG8_MMA(1, 0, At, B0); PG8_BAR; PG8_SCHED;
            PG8_STAGE(PG8_SB(0, 1), b2 + hstep, voffB);
            PG8_WAIT_V(6); PG8_BAR; PG8_MMA(1, 1, At, B1); PG8_BAR;
            PG8_LDB(B0, 1, 0); PG8_SCHED; PG8_LDA(At, 1, 0); PG8_STAGE(PG8_SA(0, 1), a2 + hstep, voffA);
            PG8_WAIT_L(8); PG8_BAR; PG8_WAIT_L(0); PG8_MMA(0, 0, At, B0); PG8_BAR; PG8_SCHED;
            PG8_LDB(B1, 1, 1); PG8_STAGE(PG8_SB(1, 0), b3, voffB);
            PG8_BAR; PG8_WAIT_L(0); PG8_MMA(0, 1, At, B1); PG8_BAR;
            PG8_LDA(At, 1, 1); PG8_STAGE(PG8_SA(1, 0), a3, voffA);
            PG8_BAR; PG8_WAIT_L(0); PG8_MMA(1, 0, At, B0); PG8_BAR; PG8_SCHED;
            PG8_STAGE(PG8_SB(1, 1), b3 + hstep, voffB);
            PG8_WAIT_V(6); PG8_BAR; PG8_MMA(1, 1, At, B1); PG8_BAR;
            }
        }
        if constexpr (ALIGN_EPI) { if (wr == 0) PG8_BAR; }
        if constexpr (!Epi::AFTER_DRAIN) { E(acc, cur, ui, wr, wc, fr, fq); S.done(cur); }
        if (!has_next) break;
#pragma unroll
        for (int a = 0; a < 2; ++a)
#pragma unroll
            for (int b = 0; b < 2; ++b)
#pragma unroll
                for (int m = 0; m < 4; ++m)
#pragma unroll
                    for (int n = 0; n < 2; ++n) acc[a][b][m][n] = (f32x4){0.f, 0.f, 0.f, 0.f};
        cur = nxt; cA = nA; cB = nB; ++ui;
        if constexpr (ALIGN_EPI) { if (wr == 1) PG8_BAR; }
    }
    PG8_WAIT_V(0);
    if constexpr (!ALIGN_EPI) { if (wr == 0) PG8_BAR; }
    PG8_BAR;
    if constexpr (Epi::AFTER_DRAIN) { E.fused(acc, cur, wr, wc, fr, fq, lds, wid, lane); S.done(cur); }
#undef PG8_SA
#undef PG8_SB
#undef PG8_STAGE
#undef PG8_LDA
#undef PG8_LDB
#undef PG8_MMA
#undef PG8_WAIT_V
#undef PG8_WAIT_L
#undef PG8_BAR
#undef PG8_SCHED
}
}

constexpr int NWAVES = 8, NTHR = NWAVES * 64;
constexpr int BATCH = 8, SEQ = 4096, D = 1024, FF = 2816, M = BATCH * SEQ;
constexpr int KCONF = 31;
constexpr float RMS_EPS = 1e-6f, LN_EPS = 1e-5f;
constexpr int NPHASE = 12;
constexpr size_t MiB = 1u << 20;
constexpr size_t WS_STATS = 1 * MiB;
constexpr size_t WS_WIN = 4 * MiB, WS_WOUT = 10 * MiB, WS_PW1 = 12 * MiB, WS_PW2 = 16 * MiB;
constexpr size_t WS_WGU0 = 18 * MiB, WS_WGU1 = 29 * MiB, WS_WDN0 = 40 * MiB, WS_WDN1 = 46 * MiB;
constexpr size_t WS_XB = 64 * MiB;
constexpr size_t WS_BG = 128 * MiB, WS_CV = 192 * MiB, WS_Y = 256 * MiB;
constexpr size_t WS_GU = 320 * MiB;
constexpr size_t WS_END = 496 * MiB;
static_assert(WS_WDN1 + (size_t)D * FF * 2 <= WS_XB && WS_WGU0 + (size_t)2 * FF * D * 2 <= WS_WGU1 && WS_WDN0 + (size_t)D * FF * 2 <= WS_WDN1 && WS_GU + (size_t)M * FF * 2 <= WS_END, "d_ws map");
constexpr int RING_BYTES = 131072;
constexpr int RSL_OFF = RING_BYTES + 4096;
constexpr int LDS_BYTES = 147456;

#define GAS __attribute__((address_space(1)))
#define LAS __attribute__((address_space(3)))
typedef unsigned short bf16;
typedef unsigned v4u __attribute__((ext_vector_type(4)));
typedef unsigned v2u __attribute__((ext_vector_type(2)));
typedef float f32x4 __attribute__((ext_vector_type(4)));
typedef float f32x2 __attribute__((ext_vector_type(2)));
#define LDS_WAIT() asm volatile("s_waitcnt lgkmcnt(0)" ::: "memory")
__device__ __forceinline__ unsigned f2bf(float f) { unsigned u = __builtin_bit_cast(unsigned, f); return (u + 0x7fffu + ((u >> 16) & 1u)) >> 16; }
__device__ __forceinline__ unsigned pk2(float lo, float hi) { return pg8::cvt_pk_bf16(lo, hi); }
__device__ __forceinline__ float bf_lo(unsigned u) { return __builtin_bit_cast(float, u << 16); }
__device__ __forceinline__ float bf_hi(unsigned u) { return __builtin_bit_cast(float, u & 0xffff0000u); }
template <int CTRL> __device__ __forceinline__ float dpp_mov(float v) { return __builtin_bit_cast(float, __builtin_amdgcn_update_dpp(0, __builtin_bit_cast(int, v), CTRL, 0xF, 0xF, false)); }
__device__ __forceinline__ float wave_sum(float v) {
    v += dpp_mov<0xB1>(v); v += dpp_mov<0x4E>(v); v += dpp_mov<0x124>(v); v += dpp_mov<0x128>(v);
    const int iv = __builtin_bit_cast(int, v);
    const float a = __builtin_bit_cast(float, __builtin_amdgcn_readlane(iv, 0)), b = __builtin_bit_cast(float, __builtin_amdgcn_readlane(iv, 16));
    const float c = __builtin_bit_cast(float, __builtin_amdgcn_readlane(iv, 32)), d = __builtin_bit_cast(float, __builtin_amdgcn_readlane(iv, 48));
    return (a + b) + (c + d);
}
__device__ __forceinline__ float sigm(float x) { return __builtin_amdgcn_rcpf(1.0f + __builtin_amdgcn_exp2f(-1.4426950408889634f * x)); }

#define XB_TMO      128
#define XB_XCNT(j)  (256  + 64 * (j))
#define XB_XSUB(j)  (1280 + 64 * (j))
#define XB_XGEN(j)  (2304 + 64 * (j))
#define XB_TOP      3328
#define XB_TOPGEN   3392
#define XCD_BAR_WORDS 3456
#define XB_SPIN_CAP (1u << 18)

__device__ __forceinline__ unsigned xb_ld(unsigned* p)              { return __hip_atomic_load(p, __ATOMIC_RELAXED, __HIP_MEMORY_SCOPE_AGENT); }
__device__ __forceinline__ unsigned xb_add(unsigned* p, unsigned v) { return __hip_atomic_fetch_add(p, v, __ATOMIC_RELAXED, __HIP_MEMORY_SCOPE_AGENT); }
__device__ __forceinline__ unsigned xb_xcc_id() { return (unsigned)__builtin_amdgcn_s_getreg((3 << 11) | 20) & 0xFu; }
#define XB_SPIN(cond, bar) do { unsigned _sp = 0; while (cond) { __builtin_amdgcn_s_sleep(1); \
    if ((++_sp & 255u) == 0u) { if (xb_ld(&(bar)[XB_TMO])) break; if (_sp > XB_SPIN_CAP) { atomicAdd(&(bar)[XB_TMO], 1u); break; } } } } while (0)

struct XcdBarrier {
    unsigned* bar; unsigned x;
    volatile LAS unsigned* st;
};

__device__ __forceinline__ XcdBarrier xcd_barrier_post(unsigned* bar, volatile LAS unsigned* st) {
    XcdBarrier b; b.bar = bar; b.x = xb_xcc_id(); b.st = st;
    if (threadIdx.x == 0) (void)xb_add(&bar[XB_XCNT(b.x)], 1u);
    return b;
}
__device__ __forceinline__ void xcd_barrier_complete(unsigned* bar, unsigned x, unsigned& nloc, unsigned& nx) {
    const unsigned G = gridDim.x * gridDim.y * gridDim.z;
    unsigned sum, cnt, mine, sp = 0u;
    for (;;) {
        sum = 0u; cnt = 0u; mine = 0u;
#pragma unroll
        for (unsigned j = 0; j < 16; ++j) { const unsigned c = xb_ld(&bar[XB_XCNT(j)]); sum += c; cnt += (c > 0u) ? 1u : 0u; mine = (j == x) ? c : mine; }
        if (sum == G) break;
        __builtin_amdgcn_s_sleep(1);
        if ((++sp & 255u) == 0u) { if (xb_ld(&bar[XB_TMO])) break; if (sp > XB_SPIN_CAP) { atomicAdd(&bar[XB_TMO], 1u); break; } }
    }
    nloc = mine > 0u ? mine : 1u; nx = cnt > 0u ? cnt : 1u;
}

__device__ __forceinline__ void xcd_barrier(const XcdBarrier& b, bool local) {
    asm volatile("s_waitcnt vmcnt(0)" ::: "memory");
    __syncthreads();
    if (threadIdx.x == 0) {
        unsigned* bar = b.bar;
        __builtin_amdgcn_s_waitcnt(0);
        unsigned nloc = b.st[0], nx = b.st[1];
        if (nloc == 0u) { xcd_barrier_complete(bar, b.x, nloc, nx); b.st[0] = nloc; b.st[1] = nx; }
        const unsigned old = xb_add(&bar[XB_XSUB(b.x)], 1u);
        const unsigned gen = old / nloc;
        if (old + 1u == (gen + 1u) * nloc) {
          if (!local) {
            __builtin_amdgcn_fence(__ATOMIC_RELEASE, "agent");
            asm volatile("s_waitcnt vmcnt(0)" ::: "memory");
            const unsigned og = xb_add(&bar[XB_TOP], 1u);
            const unsigned tg = og / nx;
            if (og + 1u == (tg + 1u) * nx) xb_add(&bar[XB_TOPGEN], 1u);
            else XB_SPIN(xb_ld(&bar[XB_TOPGEN]) == tg, bar);
          }
            __builtin_amdgcn_fence(__ATOMIC_ACQUIRE, "agent");
            xb_add(&bar[XB_XGEN(b.x)], 1u);
            asm volatile("s_waitcnt vmcnt(0)" ::: "memory");
        } else {
            XB_SPIN(xb_ld(&bar[XB_XGEN(b.x)]) == gen, bar);
            __builtin_amdgcn_fence(__ATOMIC_ACQUIRE, "agent");
            asm volatile("s_waitcnt vmcnt(0)" ::: "memory");
        }
    }
    __syncthreads();
}

__device__ __forceinline__ void p0_transpose_item(const float* W, int K, int N, const float* gain, bf16* WT, int kb, int n0, int drow0, LAS float* scr, int lane) {
    const int k0 = 64 * kb;
#pragma unroll 8
    for (int i = 0; i < 32; ++i) { const int kk = 2 * i + (lane >> 5); scr[kk * 33 + (lane & 31)] = __builtin_nontemporal_load(W + (size_t)(k0 + kk) * N + n0 + (lane & 31)); }
    LDS_WAIT(); asm volatile("" ::: "memory");
    const int c = lane & 7;
    float gk[8];
#pragma unroll
    for (int e = 0; e < 8; ++e) gk[e] = gain ? gain[k0 + 8 * c + e] : 1.0f;
#pragma unroll
    for (int j = 0; j < 4; ++j) { const int n = (lane >> 3) + 8 * j; const LAS float* s = scr + (8 * c) * 33 + n;
        v4u o; o.x = pk2(s[0 * 33] * gk[0], s[1 * 33] * gk[1]); o.y = pk2(s[2 * 33] * gk[2], s[3 * 33] * gk[3]); o.z = pk2(s[4 * 33] * gk[4], s[5 * 33] * gk[5]); o.w = pk2(s[6 * 33] * gk[6], s[7 * 33] * gk[7]);
        __builtin_nontemporal_store(o, (GAS v4u*)(WT + (size_t)(drow0 + n) * K + k0 + 8 * c)); }
    LDS_WAIT(); asm volatile("" ::: "memory");
}
__device__ __forceinline__ int inter128(int j, int h) { return 256 * (j >> 7) + 128 * h + (j & 127); }

#define FILL_RSL(S) do { LAS float* rsl_ = (LAS float*)(lds + RSL_OFF); f32x4 t_[6]; \
        _Pragma("unroll") for (int j_ = 0; j_ < 6; ++j_) { pg8::Unit u_; t_[j_] = (f32x4){1.f, 1.f, 1.f, 1.f};        \
            if (S.next((tid >> 8) + 2 * j_, u_)) t_[j_] = *(const f32x4*)(STATS + (size_t)(u_.pm * 256 + (tid & 255)) * pg8::NSTAT); } \
        _Pragma("unroll") for (int j_ = 0; j_ < 6; ++j_) rsl_[((tid >> 8) + 2 * j_) * 256 + (tid & 255)] = 1.0f / sqrtf(((t_[j_][0] + t_[j_][1]) + (t_[j_][2] + t_[j_][3])) * (1.0f / D) + RMS_EPS); \
        __syncthreads(); } while (0)
struct Args { const float* in[19]; float* out; unsigned char* ws; int ph_lo, ph_hi; };

__global__ void __launch_bounds__(NTHR, 2) trunk_fwd(Args args) {
    extern __shared__ __attribute__((aligned(16))) unsigned char lds_raw[];
    LAS unsigned char* lds = (LAS unsigned char*)lds_raw;
    const int tid = threadIdx.x, lane = tid & 63, wave = __builtin_amdgcn_readfirstlane(tid >> 6);
    const int G = gridDim.x, bid = blockIdx.x;
    unsigned char* ws = args.ws;
    const float* x = args.in[0];
    const float *a_norm = args.in[1], *a_w_in = args.in[2], *a_conv = args.in[3], *a_w_out = args.in[4];
    const float *b_norm = args.in[5], *b_w_pw1 = args.in[6], *b_b_pw1 = args.in[7], *b_conv = args.in[8], *b_b_conv = args.in[9], *b_ln_g = args.in[10], *b_ln_b = args.in[11], *b_w_pw2 = args.in[12], *b_b_pw2 = args.in[13];
    const float *ffn_norm = args.in[14], *ffn_w_gate = args.in[15], *ffn_w_up = args.in[16], *ffn_w_down = args.in[17], *final_norm = args.in[18];
    float* out = args.out;
    float* STATS = (float*)(ws + WS_STATS);
    bf16 *Win_t = (bf16*)(ws + WS_WIN), *Wout_t = (bf16*)(ws + WS_WOUT), *Wpw1_t = (bf16*)(ws + WS_PW1), *Wpw2_t = (bf16*)(ws + WS_PW2);
    bf16 *XB = (bf16*)(ws + WS_XB), *BG = (bf16*)(ws + WS_BG), *CV = (bf16*)(ws + WS_CV), *Y = (bf16*)(ws + WS_Y), *GU = (bf16*)(ws + WS_GU);
    const int lo = args.ph_lo, hi = args.ph_hi;
#if !MK_PER_PHASE
    volatile LAS unsigned* bst = (volatile LAS unsigned*)(lds + RING_BYTES);
    if (tid < 4) bst[tid] = 0u;
    __syncthreads();
    XcdBarrier bar; bar.bar = (unsigned*)ws; bar.x = xb_xcc_id(); bar.st = bst;
    if (tid == 0) bst[2] = xb_add(&bar.bar[XB_XCNT(bar.x)], 1u);
    if (lo < 0) cg::this_grid().sync();
#endif
#define IN(k) (lo <= (k) && (k) < hi)
#if MK_PER_PHASE
#define XLOCAL() false
#define VBLK() bid
#define CVID() bid
#else
#define XLOCAL() ((__builtin_amdgcn_readfirstlane(bst[3]) >> 16) != 0)
#define VBLK() ((int)((__builtin_amdgcn_readfirstlane(bst[3]) >> 16) ? (__builtin_amdgcn_readfirstlane(bst[3]) & 0xffffu) : (unsigned)bid))
#define CVID() ((int)((__builtin_amdgcn_readfirstlane(bst[3]) >> 16) ? ((__builtin_amdgcn_readfirstlane(bst[3]) & 31u) * 8u + ((__builtin_amdgcn_readfirstlane(bst[3]) & 0xffffu) >> 5)) : (unsigned)bid))
#endif
#if MK_PER_PHASE
#define SEAM(k) do { } while (0)
#else
#define SEAM(k) do { if (IN(k) && IN((k) + 1)) { xcd_barrier(bar, XLOCAL()); } } while (0)
#endif

    if (IN(0)) {
        LAS float* scr = (LAS float*)(lds + wave * 16384);
        const int gw = bid * NWAVES + wave, NGW = G * NWAVES;
        constexpr int I_IN = 16 * 96, I_SQ = 16 * 32, I_PW1 = 16 * 64, I_GU = 16 * 88, I_DN = 44 * 32;
        constexpr int NITEMS = I_IN + 2 * I_SQ + I_PW1 + 4 * I_GU + 2 * I_DN;
        for (int it = gw; it < NITEMS; it += NGW) {
            int r = it;
            if (r < I_IN) { const int kb = r / 96, n0 = 32 * (r % 96); const int dr = n0 < 1024 ? 2048 + n0 : (n0 < 2048 ? inter128(n0 - 1024, 0) : inter128(n0 - 2048, 1));
                p0_transpose_item(a_w_in, D, 3 * D, a_norm, Win_t, kb, n0, dr, scr, lane); continue; } r -= I_IN;
            if (r < I_SQ) { const int kb = r / 32, n0 = 32 * (r % 32); p0_transpose_item(a_w_out, D, D, nullptr, Wout_t, kb, n0, n0, scr, lane); continue; } r -= I_SQ;
            if (r < I_SQ) { const int kb = r / 32, n0 = 32 * (r % 32); p0_transpose_item(b_w_pw2, D, D, nullptr, Wpw2_t, kb, n0, n0, scr, lane); continue; } r -= I_SQ;
            if (r < I_PW1) { const int kb = r / 64, n0 = 32 * (r % 64); const int dr = n0 < 1024 ? inter128(n0, 0) : inter128(n0 - 1024, 1);
                p0_transpose_item(b_w_pw1, D, 2 * D, b_norm, Wpw1_t, kb, n0, dr, scr, lane); continue; } r -= I_PW1;
            if (r < 4 * I_GU) { const int q = r / I_GU, rr = r % I_GU, layer = q >> 1, hsel = q & 1; const int kb = rr / 88, n0 = 32 * (rr % 88);
                const float* W = (hsel ? ffn_w_up : ffn_w_gate) + (size_t)layer * D * FF; bf16* WT = (bf16*)(ws + (layer ? WS_WGU1 : WS_WGU0));
                p0_transpose_item(W, D, FF, ffn_norm + layer * D, WT, kb, n0, inter128(n0, hsel), scr, lane); continue; } r -= 4 * I_GU;
            { const int layer = r / I_DN, rr = r % I_DN; const int kb = rr / 32, n0 = 32 * (rr % 32);
                p0_transpose_item(ffn_w_down + (size_t)layer * FF * D, FF, D, nullptr, (bf16*)(ws + (layer ? WS_WDN1 : WS_WDN0)), kb, n0, n0, scr, lane); }
        }
        for (int m = gw; m < M; m += NGW) {
            const GAS f32x4* xr = (const GAS f32x4*)(x + (size_t)m * D) + lane; f32x4 v[4]; float s = 0.f;
#pragma unroll
            for (int j = 0; j < 4; ++j) { v[j] = __builtin_nontemporal_load(xr + 64 * j); s += (v[j].x * v[j].x + v[j].y * v[j].y) + (v[j].z * v[j].z + v[j].w * v[j].w); }
            s = wave_sum(s);
            GAS v2u* o8 = (GAS v2u*)(XB + (size_t)m * D) + lane;
#pragma unroll
            for (int j = 0; j < 4; ++j) { v2u o; o.x = pk2(v[j].x, v[j].y); o.y = pk2(v[j].z, v[j].w); __builtin_nontemporal_store(o, o8 + 64 * j); }
            if (lane == 0) *(GAS f32x4*)(STATS + (size_t)m * pg8::NSTAT) = (f32x4){s, 0.f, 0.f, 0.f};
        }
    }
    SEAM(0);
#if !MK_PER_PHASE
    if (IN(0) && IN(1)) {
        if (tid == 0) { unsigned ok = (G == 256) ? 1u : 0u, npop = 0u, xi = 0u;
            for (unsigned j = 0; j < 16; ++j) { const unsigned c = xb_ld(&bar.bar[XB_XCNT(j)]); if (c) { ok &= (c == 32u) ? 1u : 0u; ++npop; if (j < bar.x) ++xi; } }
            ok &= (npop == 8u) ? 1u : 0u;
            bst[3] = ok ? (0x10000u | (xi * 32u + bst[2])) : 0u; }
        __syncthreads();
    }
#endif
    if (IN(1)) {
        pg8::Gemm g{XB, Win_t, M, 3 * D, D}; pg8::StaticOrder S; S.init(M, 3 * D, G, CVID());
        FILL_RSL(S); pg8::EpiPair<2> E{CV, D, BG, (const LAS float*)(lds + RSL_OFF), nullptr};
        pg8::gemm_phase<pg8::EpiPair<2>, pg8::StaticOrder, true, true>(lds, g, S, E);
    }
    SEAM(1);
    if (IN(2)) {
        const int cg8 = tid & 127, sub = tid >> 7;
        float w0[8], w1[8], w2[8];
#pragma unroll
        for (int e = 0; e < 8; ++e) { w0[e] = a_conv[8 * cg8 + e]; w1[e] = a_conv[D + 8 * cg8 + e]; w2[e] = a_conv[2 * D + 8 * cg8 + e]; }
        constexpr int CH = 32;
        for (int chunk = VBLK() * 4 + sub; chunk < M / CH; chunk += G * 4) {
            const int t0 = chunk * CH; const bool first = (t0 & (SEQ - 1)) == 0;
            const GAS v4u* cvp = (const GAS v4u*)(CV + (size_t)t0 * D + 8 * cg8); const GAS v4u* bgp = (const GAS v4u*)(BG + (size_t)t0 * D + 8 * cg8); GAS v4u* yp = (GAS v4u*)(Y + (size_t)t0 * D + 8 * cg8);
            float p2[8], p1[8];
            { v4u a = (v4u){0u, 0u, 0u, 0u}, b = a; if (!first) { a = cvp[-2 * (D / 8)]; b = cvp[-1 * (D / 8)]; }
#pragma unroll
              for (int e = 0; e < 4; ++e) { p2[2 * e] = bf_lo(a[e]); p2[2 * e + 1] = bf_hi(a[e]); p1[2 * e] = bf_lo(b[e]); p1[2 * e + 1] = bf_hi(b[e]); } }
#pragma unroll 8
            for (int t = 0; t < CH; ++t) {
                const v4u c = __builtin_nontemporal_load(cvp + t * (D / 8)), bgv = __builtin_nontemporal_load(bgp + t * (D / 8)); float cur[8], o[8];
#pragma unroll
                for (int e = 0; e < 4; ++e) { cur[2 * e] = bf_lo(c[e]); cur[2 * e + 1] = bf_hi(c[e]); }
#pragma unroll
                for (int e = 0; e < 4; ++e) { o[2 * e] = bf_lo(bgv[e]) * (w0[2 * e] * p2[2 * e] + w1[2 * e] * p1[2 * e] + w2[2 * e] * cur[2 * e]);
                                              o[2 * e + 1] = bf_hi(bgv[e]) * (w0[2 * e + 1] * p2[2 * e + 1] + w1[2 * e + 1] * p1[2 * e + 1] + w2[2 * e + 1] * cur[2 * e + 1]); }
                v4u ov; ov.x = pk2(o[0], o[1]); ov.y = pk2(o[2], o[3]); ov.z = pk2(o[4], o[5]); ov.w = pk2(o[6], o[7]);
                yp[t * (D / 8)] = ov;
#pragma unroll
                for (int e = 0; e < 8; ++e) { p2[e] = p1[e]; p1[e] = cur[e]; }
            }
        }
    }
    SEAM(2);
    if (IN(3)) {
        pg8::Gemm g{Y, Wout_t, M, D, D}; pg8::StaticOrder S; S.init(M, D, G, CVID());
        pg8::EpiRes E{XB, STATS, nullptr, (LAS float*)(lds + RSL_OFF)};
        pg8::gemm_phase<pg8::EpiRes, pg8::StaticOrder, true, true>(lds, g, S, E);
    }
    SEAM(3);
    if (IN(4)) {
        pg8::Gemm g{XB, (const bf16*)(ws + WS_WGU0), M, 2 * FF, D}; pg8::StaticOrder S; S.init(M, 2 * FF, G, CVID());
        FILL_RSL(S); pg8::EpiPair<0> E{GU, FF, nullptr, (const LAS float*)(lds + RSL_OFF), nullptr};
        pg8::gemm_phase<pg8::EpiPair<0>, pg8::StaticOrder, true, true>(lds, g, S, E);
    }
    SEAM(4);
    if (IN(5)) {
        pg8::Gemm g{GU, (const bf16*)(ws + WS_WDN0), M, D, FF}; pg8::StaticOrder S; S.init(M, D, G, CVID());
        pg8::EpiRes E{XB, STATS, nullptr, (LAS float*)(lds + RSL_OFF)};
        pg8::gemm_phase<pg8::EpiRes, pg8::StaticOrder, true, true>(lds, g, S, E);
    }
    SEAM(5);
    if (IN(6)) {
        pg8::Gemm g{XB, Wpw1_t, M, 2 * D, D}; pg8::StaticOrder S; S.init(M, 2 * D, G, CVID());
        FILL_RSL(S); pg8::EpiPair<1> E{BG, D, nullptr, (const LAS float*)(lds + RSL_OFF), b_b_pw1};
        pg8::gemm_phase<pg8::EpiPair<1>, pg8::StaticOrder, true, true>(lds, g, S, E);
    }
    SEAM(6);
    if (IN(7)) {
        const int c0 = 2 * tid;
        f32x2 w[KCONF];
#pragma unroll
        for (int k = 0; k < KCONF; ++k) w[k] = *(const f32x2*)(b_conv + k * D + c0);
        const f32x2 cb = *(const f32x2*)(b_b_conv + c0);
        f32x4 lng4[4], lnb4[4];
#pragma unroll
        for (int j = 0; j < 4; ++j) { lng4[j] = *(const f32x4*)(b_ln_g + 4 * lane + 256 * j); lnb4[j] = *(const f32x4*)(b_ln_b + 4 * lane + 256 * j); }
        constexpr int TT = 16, NTILE = M / TT; const int per = (NTILE + G - 1) / G, tb = VBLK() * per, te = (tb + per < NTILE) ? tb + per : NTILE, nt_ = te - tb;
        unsigned xr[30 + TT];
        if (nt_ > 0) { const int t0 = tb * TT; const bool first = (t0 & (SEQ - 1)) == 0; const GAS unsigned* src = (const GAS unsigned*)(BG + (size_t)t0 * D + c0);
#pragma unroll
            for (int s = 0; s < 30 + TT; ++s) { const bool pad = first && s < 30; const unsigned u = src[(long)(pad ? 0 : s - 30) * (D / 2)]; xr[s] = pad ? 0u : u; } }
#define P7_CONV(i_) do { f32x2 acc[TT]; \
            _Pragma("unroll") for (int t = 0; t < TT; ++t) acc[t] = cb; \
            _Pragma("unroll") for (int s = 0; s < 30 + TT; ++s) { const f32x2 xv = (f32x2){bf_lo(xr[s]), bf_hi(xr[s])}; \
                _Pragma("unroll") for (int t = (s > 30 ? s - 30 : 0); t <= (s < TT ? s : TT - 1); ++t) acc[t] += w[s - t] * xv; } \
            LAS float* Tw = (LAS float*)(lds + ((i_) & 1) * 65536); \
            _Pragma("unroll") for (int t = 0; t < TT; ++t) *(LAS f32x2*)(Tw + t * D + c0) = acc[t]; } while (0)
#define P7_LN(i_) do { const LAS float* Tr = (const LAS float*)(lds + ((i_) & 1) * 65536); const int tbase = (tb + (i_)) * TT; \
            _Pragma("unroll") for (int q = 0; q < 2; ++q) { const int t = wave * 2 + q; f32x4 v[4]; float s = 0.f, s2 = 0.f; \
                _Pragma("unroll") for (int j = 0; j < 4; ++j) { v[j] = *(const LAS f32x4*)(Tr + t * D + 4 * lane + 256 * j); s += (v[j].x + v[j].y) + (v[j].z + v[j].w); s2 += (v[j].x * v[j].x + v[j].y * v[j].y) + (v[j].z * v[j].z + v[j].w * v[j].w); } \
                const float mean = wave_sum(s) * (1.f / D); const float var = fmaxf(wave_sum(s2) * (1.f / D) - mean * mean, 0.f); \
                const float rstd = 1.f / sqrtf(var + LN_EPS); \
                GAS v2u* o8 = (GAS v2u*)(CV + (size_t)(tbase + t) * D) + lane; \
                _Pragma("unroll") for (int j = 0; j < 4; ++j) { const f32x4 gg = lng4[j], bb = lnb4[j]; \
                    f32x4 y = (v[j] - mean) * rstd * gg + bb; y.x *= sigm(y.x); y.y *= sigm(y.y); y.z *= sigm(y.z); y.w *= sigm(y.w); \
                    v2u o; o.x = pk2(y.x, y.y); o.y = pk2(y.z, y.w); o8[64 * j] = o; } } } while (0)
        for (int i = 0; i <= nt_; ++i) {
            unsigned xn[TT];
            if (i + 1 < nt_) { const GAS unsigned* src = (const GAS unsigned*)(BG + (size_t)((tb + i + 1) * TT) * D + c0);
#pragma unroll
                for (int s = 0; s < TT; ++s) xn[s] = __builtin_nontemporal_load(src + (long)s * (D / 2)); }
            else {
#pragma unroll
                for (int s = 0; s < TT; ++s) xn[s] = 0u; }
            if (i == 0) { P7_CONV(i); }
            else if (i == nt_) { P7_LN(i - 1); }
            else if (wave < 4) { P7_CONV(i); P7_LN(i - 1); }
            else { P7_LN(i - 1); P7_CONV(i); }
            __syncthreads();
            const bool nfirst = (((tb + i + 1) * TT) & (SEQ - 1)) == 0;
#pragma unroll
            for (int s = 0; s < 30; ++s) xr[s] = nfirst ? 0u : xr[s + TT];
#pragma unroll
            for (int s = 0; s < TT; ++s) xr[30 + s] = xn[s];
        }
#undef P7_CONV
#undef P7_LN
    }
    SEAM(7);
    if (IN(8)) {
        pg8::Gemm g{CV, Wpw2_t, M, D, D}; pg8::StaticOrder S; S.init(M, D, G, CVID());
        pg8::EpiRes E{XB, STATS, b_b_pw2, (LAS float*)(lds + RSL_OFF)};
        pg8::gemm_phase<pg8::EpiRes, pg8::StaticOrder, true, true>(lds, g, S, E);
    }
    SEAM(8);
    if (IN(9)) {
        pg8::Gemm g{XB, (const bf16*)(ws + WS_WGU1), M, 2 * FF, D}; pg8::StaticOrder S; S.init(M, 2 * FF, G, CVID());
        FILL_RSL(S); pg8::EpiPair<0> E{GU, FF, nullptr, (const LAS float*)(lds + RSL_OFF), nullptr};
        pg8::gemm_phase<pg8::EpiPair<0>, pg8::StaticOrder, true, true>(lds, g, S, E);
    }
    SEAM(9);
    if (IN(10)) {
        pg8::Gemm g{GU, (const bf16*)(ws + WS_WDN1), M, D, FF}; pg8::StaticOrder S; S.init(M, D, G, CVID());
        pg8::EpiRes E{XB, STATS, nullptr, (LAS float*)(lds + RSL_OFF)};
        pg8::gemm_phase<pg8::EpiRes, pg8::StaticOrder, true, true>(lds, g, S, E);
    }
    SEAM(10);
    if (IN(11)) {
        const int gw = bid * NWAVES + wave, NGW = G * NWAVES;
        f32x4 gn[4];
#pragma unroll
        for (int j = 0; j < 4; ++j) gn[j] = *(const f32x4*)(final_norm + 4 * lane + 256 * j);
        const int vblk11 = VBLK();
        for (int mi = 0; mi < (M / 128 + G - 1) / G * 16; ++mi) { const int blk_ = vblk11 + (mi >> 4) * G; if (blk_ >= M / 128) break; const int m = blk_ * 128 + wave * 16 + (mi & 15);
            const GAS v2u* hr = (const GAS v2u*)(XB + (size_t)m * D) + lane; v2u hv[4];
#pragma unroll
            for (int j = 0; j < 4; ++j) hv[j] = __builtin_nontemporal_load(hr + 64 * j);
            float s = lane < pg8::NSTAT ? STATS[(size_t)m * pg8::NSTAT + lane] : 0.f;
            s += __shfl_xor(s, 1); s += __shfl_xor(s, 2);
            const float r = 1.f / sqrtf(__shfl(s, 0) * (1.f / D) + RMS_EPS);
            GAS f32x4* orow = (GAS f32x4*)(out + (size_t)m * D) + lane;
#pragma unroll
            for (int j = 0; j < 4; ++j) { const f32x4 v = (f32x4){bf_lo(hv[j].x), bf_hi(hv[j].x), bf_lo(hv[j].y), bf_hi(hv[j].y)}; __builtin_nontemporal_store(v * r * gn[j], orow + 64 * j); }
        }
    }
#undef IN
#undef SEAM
}

extern "C" void kernel_launch(void* const* d_in, const int* in_sizes, int n_in, void* d_out, int out_size, void* d_ws, size_t ws_size, hipStream_t stream) {
    static int grid = 0;
    if (grid == 0) {
        if (n_in != 19 || in_sizes[0] != M * D || out_size != M * D || ws_size < WS_END) { fprintf(stderr, "kernel_launch: shape/workspace mismatch: n_in %d in0 %d out %d ws %zu (need %zu); nothing launched\n", n_in, n_in > 0 ? in_sizes[0] : -1, out_size, ws_size, (size_t)WS_END); grid = -1; return; }
        int dev = 0, cus = 0, per_cu = 0;
        if (hipGetDevice(&dev) != hipSuccess || hipDeviceGetAttribute(&cus, hipDeviceAttributeMultiprocessorCount, dev) != hipSuccess) { fprintf(stderr, "kernel_launch: device query failed\n"); grid = -1; return; }
        if (hipFuncSetAttribute((const void*)trunk_fwd, hipFuncAttributeMaxDynamicSharedMemorySize, LDS_BYTES) != hipSuccess) { fprintf(stderr, "kernel_launch: hipFuncSetAttribute failed\n"); grid = -1; return; }
        if (hipOccupancyMaxActiveBlocksPerMultiprocessor(&per_cu, (const void*)trunk_fwd, NTHR, LDS_BYTES) != hipSuccess || per_cu < 1) { fprintf(stderr, "kernel_launch: occupancy query says %d blocks/CU; using 1\n", per_cu); per_cu = 1; }
        (void)hipGetLastError();
        grid = cus * per_cu;
    }
    if (grid < 0) return;
    Args a{};
    for (int i = 0; i < 19; ++i) a.in[i] = (const float*)d_in[i];
    a.out = (float*)d_out; a.ws = (unsigned char*)d_ws;
#if MK_PER_PHASE
    for (int p = 0; p < NPHASE; ++p) { a.ph_lo = p; a.ph_hi = p + 1; hipLaunchKernelGGL(trunk_fwd, dim3(grid), dim3(NTHR), LDS_BYTES, stream, a); }
#else
    a.ph_lo = 0; a.ph_hi = NPHASE;
    if (hipMemsetAsync(d_ws, 0, 16384, stream) != hipSuccess) { fprintf(stderr, "kernel_launch: memset of the barrier words failed\n"); return; }
    void* kargs[] = {&a};
    hipError_t e = hipLaunchCooperativeKernel((const void*)trunk_fwd, dim3(grid), dim3(NTHR), kargs, LDS_BYTES, stream);
    if (e != hipSuccess) fprintf(stderr, "kernel_launch: cooperative launch failed: %s (grid %d)\n", hipGetErrorString(e), grid);
#if MK_PROBE_PHASE >= 0
    a.ph_lo = MK_PROBE_PHASE; a.ph_hi = MK_PROBE_PHASE + 1; hipLaunchKernelGGL(trunk_fwd, dim3(grid), dim3(NTHR), LDS_BYTES, stream, a);
#endif
#endif
}
```

```cpp
#include <hip/hip_runtime.h>
#include <hip/hip_cooperative_groups.h>
#include <cstdio>
#include <cstdint>
namespace cg = cooperative_groups;
#ifndef MK_PROBE_PHASE
#define MK_PROBE_PHASE -1
#endif
#ifndef MK_PER_PHASE
#define MK_PER_PHASE 0
#endif
namespace pg8 {
#define PG8_LAS __attribute__((address_space(3)))
typedef unsigned short bf16_t;
typedef short bf16x8 __attribute__((ext_vector_type(8)));
typedef float f32x4 __attribute__((ext_vector_type(4)));
typedef unsigned u32x4 __attribute__((ext_vector_type(4)));
constexpr int BM = 256, BK = 64, HALF = 128, HTB = HALF * BK * 2  , STAGE_BYTES = 8 * HTB, NXCD = 8, WGM = 8;

__host__ __device__ __forceinline__ int lds_byte(int r, int c) { const int st = (r >> 4) * 2 + (c >> 5), rr = r & 15, cc = c & 31, ob = rr * 64 + cc * 2; return st * 1024 + (ob ^ (((ob >> 9) & 1) << 5)); }
__host__ __device__ __forceinline__ void stage_rc(int b, int& R, int& C) { const int st = b / 1024, sb = b % 1024, swz = sb ^ (((sb >> 9) & 1) << 5); R = (st >> 1) * 16 + swz / 64; C = (st & 1) * 32 + (swz % 64) / 2; }
__host__ __device__ __forceinline__ int perm32(int rho) { const int n = rho >> 4, i = rho & 15; return 8 * (i >> 2) + 4 * n + (i & 3); }

struct Unit { int pm, pn; };
struct Gemm { const bf16_t* A; const bf16_t* Bt; int M, N, K; };

struct StaticOrder {
    int nM, nN, nwg, G, c;
    __host__ __device__ void init(int M, int N, int G_, int c_) { nM = M / BM; nN = N / BM; nwg = nM * nN; G = G_; c = c_; }
    __host__ __device__ bool next(int i, Unit& u) const {
        const long L = (long)i * G + c; if (L >= nwg) return false;
        int wgid = (int)L; { const int q = nwg / NXCD, r = nwg % NXCD, xcd = wgid % NXCD, off = wgid / NXCD; wgid = (xcd < r ? xcd * (q + 1) : r * (q + 1) + (xcd - r) * q) + off; }
        const int nig = WGM * nN, gid = wgid / nig, fm = gid * WGM, gsz = (nM - fm) < WGM ? (nM - fm) : WGM;
        u.pm = fm + ((wgid % nig) % gsz); u.pn = (wgid % nig) / gsz; return true;
    }
    __device__ __forceinline__ void a_ready(const Unit&) const {}
    __device__ __forceinline__ void done(const Unit&) const {}
};

__device__ __forceinline__ unsigned cvt_pk_bf16(float lo, float hi) { unsigned r; asm volatile("v_cvt_pk_bf16_f32 %0, %1, %2" : "=v"(r) : "v"(lo), "v"(hi)); return r; }
typedef float f32x2 __attribute__((ext_vector_type(2)));
__device__ __forceinline__ float sigmoid_f(float x) { return __builtin_amdgcn_rcpf(1.0f + __builtin_amdgcn_exp2f(-1.4426950408889634f * x)); }
constexpr int NSTAT = 4;
__device__ __forceinline__ void load_rscale(const float* stats, int row0, int fq, float (&rs)[2][4]) {
#pragma unroll
    for (int ai = 0; ai < 2; ++ai)
#pragma unroll
        for (int m = 0; m < 4; ++m) {
            const f32x4 p = *(const f32x4*)(stats + (size_t)(row0 + ai * HALF + m * 16) * NSTAT + fq * 4);
            float s = (p[0] + p[1]) + (p[2] + p[3]); s += __shfl_xor(s, 16); s += __shfl_xor(s, 32);
            rs[ai][m] = 1.0f / sqrtf(s * (1.0f / 1024.0f) + 1e-6f);
        }
}
__device__ __forceinline__ u32x4 pack8(const f32x4 v0, const f32x4 v1) { u32x4 w; w.x = cvt_pk_bf16(v0[0], v0[1]); w.y = cvt_pk_bf16(v0[2], v0[3]); w.z = cvt_pk_bf16(v1[0], v1[1]); w.w = cvt_pk_bf16(v1[2], v1[3]); return w; }
template <int MODE> struct EpiPair {
    static constexpr bool PERM = true, AFTER_DRAIN = false;
    bf16_t* O; int ldc; bf16_t* O2; const PG8_LAS float* rsl; const float* bias;
    __device__ __forceinline__ void operator()(const f32x4 (&acc)[2][2][4][2], const Unit& u, int ui, int wr, int wc, int fr, int fq) const {
        const int row0 = u.pm * BM + wr * 64 + fr, cw = wc * 32 + 8 * fq;
        float rs[2][4];
#pragma unroll
        for (int ai = 0; ai < 2; ++ai)
#pragma unroll
            for (int m = 0; m < 4; ++m) rs[ai][m] = rsl[ui * BM + ai * HALF + wr * 64 + m * 16 + fr];
        if (MODE == 2 && u.pn >= 8) {
#pragma unroll
            for (int ai = 0; ai < 2; ++ai)
#pragma unroll
                for (int m = 0; m < 4; ++m) { const float r = rs[ai][m]; bf16_t* rowp = O2 + (size_t)(row0 + ai * HALF + m * 16) * 1024 + (u.pn - 8) * BM + cw;
#pragma unroll
                    for (int bj = 0; bj < 2; ++bj) *(u32x4*)(rowp + bj * HALF) = pack8(acc[ai][bj][m][0] * r, acc[ai][bj][m][1] * r); }
            return;
        }
        f32x4 bp[2], bq[2];
#pragma unroll
        for (int n = 0; n < 2; ++n) { bp[n] = (f32x4){0.f, 0.f, 0.f, 0.f}; bq[n] = bp[n]; if (MODE == 1) { bp[n] = *(const f32x4*)(bias + u.pn * HALF + cw + 4 * n); bq[n] = *(const f32x4*)(bias + 1024 + u.pn * HALF + cw + 4 * n); } }
#pragma unroll
        for (int ai = 0; ai < 2; ++ai)
#pragma unroll
            for (int m = 0; m < 4; ++m) { const float r = rs[ai][m], r2 = r * r, rc = -1.4426950408889634f * r; bf16_t* rowp = O + (size_t)(row0 + ai * HALF + m * 16) * ldc + u.pn * HALF + cw;
                f32x4 o[2];
#pragma unroll
                for (int n = 0; n < 2; ++n) { const f32x4 ap = acc[ai][0][m][n], aq = acc[ai][1][m][n];
                    if (MODE == 0) { const f32x4 t = ap * rc; f32x4 d; d[0] = __builtin_amdgcn_exp2f(t[0]); d[1] = __builtin_amdgcn_exp2f(t[1]); d[2] = __builtin_amdgcn_exp2f(t[2]); d[3] = __builtin_amdgcn_exp2f(t[3]);
                        d = d + 1.0f; f32x4 s; s[0] = __builtin_amdgcn_rcpf(d[0]); s[1] = __builtin_amdgcn_rcpf(d[1]); s[2] = __builtin_amdgcn_rcpf(d[2]); s[3] = __builtin_amdgcn_rcpf(d[3]);
                        o[n] = (ap * aq) * (s * r2); }
                    else if (MODE == 1) { const f32x4 p = ap * r + bp[n], q = aq * r + bq[n], t = q * (-1.4426950408889634f); f32x4 d; d[0] = __builtin_amdgcn_exp2f(t[0]); d[1] = __builtin_amdgcn_exp2f(t[1]); d[2] = __builtin_amdgcn_exp2f(t[2]); d[3] = __builtin_amdgcn_exp2f(t[3]);
                        d = d + 1.0f; f32x4 s; s[0] = __builtin_amdgcn_rcpf(d[0]); s[1] = __builtin_amdgcn_rcpf(d[1]); s[2] = __builtin_amdgcn_rcpf(d[2]); s[3] = __builtin_amdgcn_rcpf(d[3]);
                        o[n] = p * s; }
                    else o[n] = (ap * aq) * r2; }
                if (MODE == 2) *(u32x4*)rowp = pack8(o[0], o[1]); else __builtin_nontemporal_store(pack8(o[0], o[1]), (u32x4*)rowp); }
    }
};
struct EpiRes {
    static constexpr bool PERM = true, AFTER_DRAIN = false;
    bf16_t* xb; float* stats; const float* bias; PG8_LAS float* xl;
    __device__ __forceinline__ void operator()(const f32x4 (&acc)[2][2][4][2], const Unit& u, int ui, int wr, int wc, int fr, int fq) const {
        const int row0 = u.pm * BM + wr * 64 + fr, col0 = u.pn * BM + wc * 32 + 8 * fq;
        u32x4 b[2][2][2];
#define RES_LOAD(g) do { _Pragma("unroll") for (int mm = 0; mm < 2; ++mm) _Pragma("unroll") for (int bj = 0; bj < 2; ++bj) \
            b[(g) & 1][mm][bj] = *(const u32x4*)(xb + (size_t)(row0 + ((g) >> 1) * HALF + (2 * ((g) & 1) + mm) * 16) * 1024 + col0 + bj * HALF); } while (0)
        RES_LOAD(0); RES_LOAD(1);
        asm volatile("" ::: "memory");
#pragma unroll
        for (int g = 0; g < 4; ++g) {
#pragma unroll
            for (int mm = 0; mm < 2; ++mm) { const int ai = g >> 1, m = 2 * (g & 1) + mm; const int row = row0 + ai * HALF + m * 16; bf16_t* p = xb + (size_t)row * 1024 + col0; float ss = 0.f;
#pragma unroll
                for (int bj = 0; bj < 2; ++bj) { const u32x4 bb = b[g & 1][mm][bj];
                    const f32x4 b0 = (f32x4){__builtin_bit_cast(float, bb.x << 16), __builtin_bit_cast(float, bb.x & 0xffff0000u), __builtin_bit_cast(float, bb.y << 16), __builtin_bit_cast(float, bb.y & 0xffff0000u)};
                    const f32x4 b1 = (f32x4){__builtin_bit_cast(float, bb.z << 16), __builtin_bit_cast(float, bb.z & 0xffff0000u), __builtin_bit_cast(float, bb.w << 16), __builtin_bit_cast(float, bb.w & 0xffff0000u)};
                    f32x4 v0 = b0 + acc[ai][bj][m][0], v1 = b1 + acc[ai][bj][m][1];
                    if (bias) { v0 += *(const f32x4*)(bias + col0 + bj * HALF); v1 += *(const f32x4*)(bias + col0 + bj * HALF + 4); }
                    ss += (v0[0] * v0[0] + v0[1] * v0[1]) + (v0[2] * v0[2] + v0[3] * v0[3]) + (v1[0] * v1[0] + v1[1] * v1[1]) + (v1[2] * v1[2] + v1[3] * v1[3]);
                    *(u32x4*)(p + bj * HALF) = pack8(v0, v1); }
                ss += __shfl_xor(ss, 16); ss += __shfl_xor(ss, 32); if (fq == 0) xl[wc * BM + ai * HALF + wr * 64 + m * 16 + fr] = ss; }
            asm volatile("" ::: "memory");
            if (g + 2 < 4) { RES_LOAD(g + 2); asm volatile("" ::: "memory"); }
        }
#undef RES_LOAD
        asm volatile("s_waitcnt lgkmcnt(0)" ::: "memory"); __builtin_amdgcn_s_barrier(); asm volatile("" ::: "memory");
        if (threadIdx.x < 256) { const int r = threadIdx.x; stats[(size_t)(u.pm * BM + r) * NSTAT + u.pn] = (xl[r] + xl[BM + r]) + (xl[2 * BM + r] + xl[3 * BM + r]); }
    }
};
template <class Epi, class Sched, bool ALIGN_EPI = false, bool SP2 = false>
__device__ __forceinline__ void gemm_phase(PG8_LAS unsigned char* lds, const Gemm g, const Sched& S, const Epi& E) {
    const int tid = threadIdx.x, wid = __builtin_amdgcn_readfirstlane(tid >> 6), lane = tid & 63, wr = wid >> 2, wc = wid & 3, fr = lane & 15, fq = lane >> 4;
    const int K = g.K, nt = K / BK;
    unsigned voffA[2], voffB[2];
#pragma unroll
    for (int i = 0; i < 2; ++i) { int R, C; stage_rc(tid * 16 + i * 8192, R, C); const int Rb = Epi::PERM ? ((R & ~31) + perm32(R & 31)) : R;
        voffA[i] = (unsigned)(R * K + C) * 2u; voffB[i] = (unsigned)(Rb * K + C) * 2u; }
    const size_t kstep = (size_t)(BK * 2);
    const size_t hstep = (size_t)HALF * K * 2;
    const size_t tstep = 2 * hstep;
    const unsigned ldsw = (unsigned)wid * 1024u;
    const int aoff = lds_byte(wr * 64 + fr, fq * 8), boff = lds_byte(wc * 32 + fr, fq * 8);
#define PG8_SA(b, h) (((b) * 2 + (h)) * HTB)
#define PG8_SB(b, h) ((4 + (b) * 2 + (h)) * HTB)
#define PG8_STAGE(bufoff, gbase, voff) do { _Pragma("unroll") for (int _i = 0; _i < 2; ++_i) \
        __builtin_amdgcn_global_load_lds((const unsigned*)((const char*)(gbase) + (voff)[_i]), (PG8_LAS unsigned*)(lds + (bufoff) + ldsw + _i * 8192), 16, 0, 0); } while (0)
#define PG8_LDA(dst, b, h) do { _Pragma("unroll") for (int m = 0; m < 4; ++m) _Pragma("unroll") for (int k = 0; k < 2; ++k) dst[m][k] = *(const PG8_LAS bf16x8*)(lds + PG8_SA(b, h) + aoff + m * 2048 + k * 1024); } while (0)
#define PG8_LDB(dst, b, h) do { _Pragma("unroll") for (int n = 0; n < 2; ++n) _Pragma("unroll") for (int k = 0; k < 2; ++k) dst[n][k] = *(const PG8_LAS bf16x8*)(lds + PG8_SB(b, h) + boff + n * 2048 + k * 1024); } while (0)
#define PG8_MMA(ai, bj, At, Bt) do { __builtin_amdgcn_s_setprio(1); _Pragma("unroll") for (int m = 0; m < 4; ++m) _Pragma("unroll") for (int n = 0; n < 2; ++n) _Pragma("unroll") for (int k = 0; k < 2; ++k) \
        acc[ai][bj][m][n] = __builtin_amdgcn_mfma_f32_16x16x32_bf16(Bt[n][k], At[m][k], acc[ai][bj][m][n], 0, 0, 0); __builtin_amdgcn_s_setprio(0); } while (0)
#define PG8_WAIT_V(n) asm volatile("s_waitcnt vmcnt(" #n ")" ::: "memory")
#define PG8_WAIT_L(n) asm volatile("s_waitcnt lgkmcnt(" #n ")" ::: "memory")
#define PG8_BAR __builtin_amdgcn_s_barrier()
#define PG8_SCHED __builtin_amdgcn_sched_barrier(0)
    Unit cur, nxt; int ui = 0;
    if (!S.next(0, cur)) return;
    f32x4 acc[2][2][4][2];
#pragma unroll
    for (int a = 0; a < 2; ++a)
#pragma unroll
        for (int b = 0; b < 2; ++b)
#pragma unroll
            for (int m = 0; m < 4; ++m)
#pragma unroll
                for (int n = 0; n < 2; ++n) acc[a][b][m][n] = (f32x4){0.f, 0.f, 0.f, 0.f};
    bf16x8 At[4][2], B0[2][2], B1[2][2];
    const char* cA = (const char*)g.A + (size_t)cur.pm * tstep; const char* cB = (const char*)g.Bt + (size_t)cur.pn * tstep;
    S.a_ready(cur);
    if constexpr (SP2) {
        PG8_STAGE(PG8_SB(0, 0), cB, voffB); PG8_STAGE(PG8_SB(0, 1), cB + hstep, voffB); PG8_STAGE(PG8_SA(0, 0), cA, voffA); PG8_STAGE(PG8_SA(0, 1), cA + hstep, voffA);
        if (wr == 1) PG8_BAR;
        PG8_WAIT_V(2); PG8_BAR;
        PG8_STAGE(PG8_SB(1, 0), cB + kstep, voffB); PG8_STAGE(PG8_SA(1, 0), cA + kstep, voffA); PG8_STAGE(PG8_SB(1, 1), cB + hstep + kstep, voffB);
        PG8_WAIT_V(6); PG8_BAR;
    } else {
        PG8_STAGE(PG8_SB(0, 0), cB, voffB); PG8_STAGE(PG8_SA(0, 0), cA, voffA); PG8_STAGE(PG8_SB(0, 1), cB + hstep, voffB); PG8_STAGE(PG8_SA(0, 1), cA + hstep, voffA);
        if (wr == 1) PG8_BAR;
        PG8_WAIT_V(4); PG8_BAR;
        PG8_STAGE(PG8_SB(1, 0), cB + kstep, voffB); PG8_STAGE(PG8_SA(1, 0), cA + kstep, voffA); PG8_STAGE(PG8_SB(1, 1), cB + hstep + kstep, voffB);
        PG8_WAIT_V(6); PG8_BAR;
    }
    for (;;) {
        const bool has_next = S.next(ui + 1, nxt);
        const char* nA = has_next ? (const char*)g.A + (size_t)nxt.pm * tstep : cA; const char* nB = has_next ? (const char*)g.Bt + (size_t)nxt.pn * tstep : cB;
        for (int t = 0; t < nt; t += 2) {
            const bool last = (t == nt - 2);
            const char* a1 = cA + (size_t)(t + 1) * kstep;
            const char* a2 = last ? nA : cA + (size_t)(t + 2) * kstep; const char* b2 = last ? nB : cB + (size_t)(t + 2) * kstep;
            const char* a3 = a2 + kstep; const char* b3 = b2 + kstep;
            if (last && has_next) S.a_ready(nxt);
            if constexpr (SP2) {
            PG8_LDB(B0, 0, 0); PG8_LDB(B1, 0, 1); PG8_SCHED; PG8_LDA(At, 0, 0); PG8_STAGE(PG8_SA(1, 1), a1 + hstep, voffA);
            PG8_WAIT_V(8); PG8_WAIT_L(0); PG8_BAR; PG8_MMA(0, 0, At, B0); PG8_MMA(0, 1, At, B1); PG8_BAR; PG8_SCHED;
            PG8_LDA(At, 0, 1); PG8_STAGE(PG8_SB(0, 0), b2, voffB); PG8_STAGE(PG8_SB(0, 1), b2 + hstep, voffB); PG8_STAGE(PG8_SA(0, 0), a2, voffA);
            PG8_WAIT_V(8); PG8_WAIT_L(0); PG8_BAR; PG8_MMA(1, 0, At, B0); PG8_MMA(1, 1, At, B1); PG8_BAR; PG8_SCHED;
            PG8_LDB(B0, 1, 0); PG8_LDB(B1, 1, 1); PG8_SCHED; PG8_LDA(At, 1, 0); PG8_STAGE(PG8_SA(0, 1), a2 + hstep, voffA);
            PG8_WAIT_V(8); PG8_WAIT_L(0); PG8_BAR; PG8_MMA(0, 0, At, B0); PG8_MMA(0, 1, At, B1); PG8_BAR; PG8_SCHED;
            PG8_LDA(At, 1, 1); PG8_STAGE(PG8_SB(1, 0), b3, voffB); PG8_STAGE(PG8_SB(1, 1), b3 + hstep, voffB); PG8_STAGE(PG8_SA(1, 0), a3, voffA);
            PG8_WAIT_V(8); PG8_WAIT_L(0); PG8_BAR; PG8_MMA(1, 0, At, B0); PG8_MMA(1, 1, At, B1); PG8_BAR; PG8_SCHED;
            } else {
            PG8_LDB(B0, 0, 0); PG8_SCHED; PG8_LDA(At, 0, 0); PG8_STAGE(PG8_SA(1, 1), a1 + hstep, voffA);
            PG8_WAIT_L(8); PG8_BAR; PG8_WAIT_L(0); PG8_MMA(0, 0, At, B0); PG8_BAR; PG8_SCHED;
            PG8_LDB(B1, 0, 1); PG8_STAGE(PG8_SB(0, 0), b2, voffB);
            PG8_BAR; PG8_WAIT_L(0); PG8_MMA(0, 1, At, B1); PG8_BAR;
            PG8_LDA(At, 0, 1); PG8_STAGE(PG8_SA(0, 0), a2, voffA);
            PG8_BAR; PG8_WAIT_L(0); PG8_MMA(1, 0, At, B0); PG8_BAR; PG8_SCHED;
            PG8_STAGE(PG8_SB(0, 1), b2 + hstep, voffB);
            PG8_WAIT_V(6); PG8_BAR; PG8_MMA(1, 1, At, B1); PG8_BAR;
            PG8_LDB(B0, 1, 0); PG8_SCHED; PG8_LDA(At, 1, 0); PG8_STAGE(PG8_SA(0, 1), a2 + hstep, voffA);
            PG8_WAIT_L(8); PG8_BAR; PG8_WAIT_L(0); PG8_MMA(0, 0, At, B0); PG8_BAR; PG8_SCHED;
            PG8_LDB(B1, 1, 1); PG8_STAGE(PG8_SB(1, 0), b3, voffB);
            PG8_BAR; PG8_WAIT_L(0); PG8_MMA(0, 1, At, B1); PG8_BAR;
            PG8_LDA(At, 1, 1); PG8_STAGE(PG8_SA(1, 0), a3, voffA);
            PG8_BAR; PG8_WAIT_L(0); PG8_MMA(1, 0, At, B0); PG8_BAR; PG8_SCHED;
            PG8_STAGE(PG8_SB(1, 1), b3 + hstep, voffB);
            PG8_WAIT_V(6); PG8_BAR; PG8_MMA(1, 1, At, B1); PG8_BAR;
            }
        }
        if constexpr (ALIGN_EPI) { if (wr == 0) PG8_BAR; }
        if constexpr (!Epi::AFTER_DRAIN) { E(acc, cur, ui, wr, wc, fr, fq); S.done(cur); }
        if (!has_next) break;
#pragma unroll
        for (int a = 0; a < 2; ++a)
#pragma unroll
            for (int b = 0; b < 2; ++b)
#pragma unroll
                for (int m = 0; m < 4; ++m)
#pragma unroll
                    for (int n = 0; n < 2; ++n) acc[a][b][m][n] = (f32x4){0.f, 0.f, 0.f, 0.f};
        cur = nxt; cA = nA; cB = nB; ++ui;
        if constexpr (ALIGN_EPI) { if (wr == 1) PG8_BAR; }
    }
    PG8_WAIT_V(0);
    if constexpr (!ALIGN_EPI) { if (wr == 0) PG8_BAR; }
    PG8_BAR;
    if constexpr (Epi::AFTER_DRAIN) { E.fused(acc, cur, wr, wc, fr, fq, lds, wid, lane); S.done(cur); }
#undef PG8_SA
#undef PG8_SB
#undef PG8_STAGE
#undef PG8_LDA
#undef PG8_LDB
#undef PG8_MMA
#undef PG8_WAIT_V
#undef PG8_WAIT_L
#undef PG8_BAR
#undef PG8_SCHED
}
}

constexpr int NWAVES = 8, NTHR = NWAVES * 64;
constexpr int BATCH = 8, SEQ = 4096, D = 1024, FF = 2816, M = BATCH * SEQ;
constexpr int KCONF = 31;
constexpr float RMS_EPS = 1e-6f, LN_EPS = 1e-5f;
constexpr int NPHASE = 12;
constexpr size_t MiB = 1u << 20;
constexpr size_t WS_STATS = 1 * MiB;
constexpr size_t WS_WIN = 4 * MiB, WS_WOUT = 10 * MiB, WS_PW1 = 12 * MiB, WS_PW2 = 16 * MiB;
constexpr size_t WS_WGU0 = 18 * MiB, WS_WGU1 = 29 * MiB, WS_WDN0 = 40 * MiB, WS_WDN1 = 46 * MiB;
constexpr size_t WS_XB = 64 * MiB;
constexpr size_t WS_BG = 128 * MiB, WS_CV = 192 * MiB, WS_Y = 256 * MiB;
constexpr size_t WS_GU = 320 * MiB;
constexpr size_t WS_END = 496 * MiB;
static_assert(WS_WDN1 + (size_t)D * FF * 2 <= WS_XB && WS_WGU0 + (size_t)2 * FF * D * 2 <= WS_WGU1 && WS_WDN0 + (size_t)D * FF * 2 <= WS_WDN1 && WS_GU + (size_t)M * FF * 2 <= WS_END, "d_ws map");
constexpr int RING_BYTES = 131072;
constexpr int RSL_OFF = RING_BYTES + 4096;
constexpr int LDS_BYTES = 147456;

#define GAS __attribute__((address_space(1)))
#define LAS __attribute__((address_space(3)))
typedef unsigned short bf16;
typedef unsigned v4u __attribute__((ext_vector_type(4)));
typedef unsigned v2u __attribute__((ext_vector_type(2)));
typedef float f32x4 __attribute__((ext_vector_type(4)));
typedef float f32x2 __attribute__((ext_vector_type(2)));
#define LDS_WAIT() asm volatile("s_waitcnt lgkmcnt(0)" ::: "memory")
__device__ __forceinline__ unsigned f2bf(float f) { unsigned u = __builtin_bit_cast(unsigned, f); return (u + 0x7fffu + ((u >> 16) & 1u)) >> 16; }
__device__ __forceinline__ unsigned pk2(float lo, float hi) { return pg8::cvt_pk_bf16(lo, hi); }
__device__ __forceinline__ float bf_lo(unsigned u) { return __builtin_bit_cast(float, u << 16); }
__device__ __forceinline__ float bf_hi(unsigned u) { return __builtin_bit_cast(float, u & 0xffff0000u); }
template <int CTRL> __device__ __forceinline__ float dpp_mov(float v) { return __builtin_bit_cast(float, __builtin_amdgcn_update_dpp(0, __builtin_bit_cast(int, v), CTRL, 0xF, 0xF, false)); }
__device__ __forceinline__ float wave_sum(float v) {
    v += dpp_mov<0xB1>(v); v += dpp_mov<0x4E>(v); v += dpp_mov<0x124>(v); v += dpp_mov<0x128>(v);
    const int iv = __builtin_bit_cast(int, v);
    const float a = __builtin_bit_cast(float, __builtin_amdgcn_readlane(iv, 0)), b = __builtin_bit_cast(float, __builtin_amdgcn_readlane(iv, 16));
    const float c = __builtin_bit_cast(float, __builtin_amdgcn_readlane(iv, 32)), d = __builtin_bit_cast(float, __builtin_amdgcn_readlane(iv, 48));
    return (a + b) + (c + d);
}
__device__ __forceinline__ float sigm(float x) { return __builtin_amdgcn_rcpf(1.0f + __builtin_amdgcn_exp2f(-1.4426950408889634f * x)); }

#define XB_TMO      128
#define XB_XCNT(j)  (256  + 64 * (j))
#define XB_XSUB(j)  (1280 + 64 * (j))
#define XB_XGEN(j)  (2304 + 64 * (j))
#define XB_TOP      3328
#define XB_TOPGEN   3392
#define XCD_BAR_WORDS 3456
#define XB_SPIN_CAP (1u << 18)

__device__ __forceinline__ unsigned xb_ld(unsigned* p)              { return __hip_atomic_load(p, __ATOMIC_RELAXED, __HIP_MEMORY_SCOPE_AGENT); }
__device__ __forceinline__ unsigned xb_add(unsigned* p, unsigned v) { return __hip_atomic_fetch_add(p, v, __ATOMIC_RELAXED, __HIP_MEMORY_SCOPE_AGENT); }
__device__ __forceinline__ unsigned xb_xcc_id() { return (unsigned)__builtin_amdgcn_s_getreg((3 << 11) | 20) & 0xFu; }
#define XB_SPIN(cond, bar) do { unsigned _sp = 0; while (cond) { __builtin_amdgcn_s_sleep(1); \
    if ((++_sp & 255u) == 0u) { if (xb_ld(&(bar)[XB_TMO])) break; if (_sp > XB_SPIN_CAP) { atomicAdd(&(bar)[XB_TMO], 1u); break; } } } } while (0)

struct XcdBarrier {
    unsigned* bar; unsigned x;
    volatile LAS unsigned* st;
};

__device__ __forceinline__ XcdBarrier xcd_barrier_post(unsigned* bar, volatile LAS unsigned* st) {
    XcdBarrier b; b.bar = bar; b.x = xb_xcc_id(); b.st = st;
    if (threadIdx.x == 0) (void)xb_add(&bar[XB_XCNT(b.x)], 1u);
    return b;
}
__device__ __forceinline__ void xcd_barrier_complete(unsigned* bar, unsigned x, unsigned& nloc, unsigned& nx) {
    const unsigned G = gridDim.x * gridDim.y * gridDim.z;
    unsigned sum, cnt, mine, sp = 0u;
    for (;;) {
        sum = 0u; cnt = 0u; mine = 0u;
#pragma unroll
        for (unsigned j = 0; j < 16; ++j) { const unsigned c = xb_ld(&bar[XB_XCNT(j)]); sum += c; cnt += (c > 0u) ? 1u : 0u; mine = (j == x) ? c : mine; }
        if (sum == G) break;
        __builtin_amdgcn_s_sleep(1);
        if ((++sp & 255u) == 0u) { if (xb_ld(&bar[XB_TMO])) break; if (sp > XB_SPIN_CAP) { atomicAdd(&bar[XB_TMO], 1u); break; } }
    }
    nloc = mine > 0u ? mine : 1u; nx = cnt > 0u ? cnt : 1u;
}

__device__ __forceinline__ void xcd_barrier(const XcdBarrier& b, bool local) {
    asm volatile("s_waitcnt vmcnt(0)" ::: "memory");
    __syncthreads();
    if (threadIdx.x == 0) {
        unsigned* bar = b.bar;
        __builtin_amdgcn_s_waitcnt(0);
        unsigned nloc = b.st[0], nx = b.st[1];
        if (nloc == 0u) { xcd_barrier_complete(bar, b.x, nloc, nx); b.st[0] = nloc; b.st[1] = nx; }
        const unsigned old = xb_add(&bar[XB_XSUB(b.x)], 1u);
        const unsigned gen = old / nloc;
        if (old + 1u == (gen + 1u) * nloc) {
          if (!local) {
            __builtin_amdgcn_fence(__ATOMIC_RELEASE, "agent");
            asm volatile("s_waitcnt vmcnt(0)" ::: "memory");
            const unsigned og = xb_add(&bar[XB_TOP], 1u);
            const unsigned tg = og / nx;
            if (og + 1u == (tg + 1u) * nx) xb_add(&bar[XB_TOPGEN], 1u);
            else XB_SPIN(xb_ld(&bar[XB_TOPGEN]) == tg, bar);
          }
            __builtin_amdgcn_fence(__ATOMIC_ACQUIRE, "agent");
            xb_add(&bar[XB_XGEN(b.x)], 1u);
            asm volatile("s_waitcnt vmcnt(0)" ::: "memory");
        } else {
            XB_SPIN(xb_ld(&bar[XB_XGEN(b.x)]) == gen, bar);
            __builtin_amdgcn_fence(__ATOMIC_ACQUIRE, "agent");
            asm volatile("s_waitcnt vmcnt(0)" ::: "memory");
        }
    }
    __syncthreads();
}

__device__ __forceinline__ void p0_transpose_item(const float* W, int K, int N, const float* gain, bf16* WT, int kb, int n0, int drow0, LAS float* scr, int lane) {
    const int k0 = 64 * kb;
#pragma unroll 8
    for (int i = 0; i < 32; ++i) { const int kk = 2 * i + (lane >> 5); scr[kk * 33 + (lane & 31)] = __builtin_nontemporal_load(W + (size_t)(k0 + kk) * N + n0 + (lane & 31)); }
    LDS_WAIT(); asm volatile("" ::: "memory");
    const int c = lane & 7;
    float gk[8];
#pragma unroll
    for (int e = 0; e < 8; ++e) gk[e] = gain ? gain[k0 + 8 * c + e] : 1.0f;
#pragma unroll
    for (int j = 0; j < 4; ++j) { const int n = (lane >> 3) + 8 * j; const LAS float* s = scr + (8 * c) * 33 + n;
        v4u o; o.x = pk2(s[0 * 33] * gk[0], s[1 * 33] * gk[1]); o.y = pk2(s[2 * 33] * gk[2], s[3 * 33] * gk[3]); o.z = pk2(s[4 * 33] * gk[4], s[5 * 33] * gk[5]); o.w = pk2(s[6 * 33] * gk[6], s[7 * 33] * gk[7]);
        __builtin_nontemporal_store(o, (GAS v4u*)(WT + (size_t)(drow0 + n) * K + k0 + 8 * c)); }
    LDS_WAIT(); asm volatile("" ::: "memory");
}
__device__ __forceinline__ int inter128(int j, int h) { return 256 * (j >> 7) + 128 * h + (j & 127); }

#define FILL_RSL(S) do { LAS float* rsl_ = (LAS float*)(lds + RSL_OFF); f32x4 t_[6]; \
        _Pragma("unroll") for (int j_ = 0; j_ < 6; ++j_) { pg8::Unit u_; t_[j_] = (f32x4){1.f, 1.f, 1.f, 1.f};        \
            if (S.next((tid >> 8) + 2 * j_, u_)) t_[j_] = *(const f32x4*)(STATS + (size_t)(u_.pm * 256 + (tid & 255)) * pg8::NSTAT); } \
        _Pragma("unroll") for (int j_ = 0; j_ < 6; ++j_) rsl_[((tid >> 8) + 2 * j_) * 256 + (tid & 255)] = 1.0f / sqrtf(((t_[j_][0] + t_[j_][1]) + (t_[j_][2] + t_[j_][3])) * (1.0f / D) + RMS_EPS); \
        __syncthreads(); } while (0)
struct Args { const float* in[19]; float* out; unsigned char* ws; int ph_lo, ph_hi; };

__global__ void __launch_bounds__(NTHR, 2) trunk_fwd(Args args) {
    extern __shared__ __attribute__((aligned(16))) unsigned char lds_raw[];
    LAS unsigned char* lds = (LAS unsigned char*)lds_raw;
    const int tid = threadIdx.x, lane = tid & 63, wave = __builtin_amdgcn_readfirstlane(tid >> 6);
    const int G = gridDim.x, bid = blockIdx.x;
    unsigned char* ws = args.ws;
    const float* x = args.in[0];
    const float *a_norm = args.in[1], *a_w_in = args.in[2], *a_conv = args.in[3], *a_w_out = args.in[4];
    const float *b_norm = args.in[5], *b_w_pw1 = args.in[6], *b_b_pw1 = args.in[7], *b_conv = args.in[8], *b_b_conv = args.in[9], *b_ln_g = args.in[10], *b_ln_b = args.in[11], *b_w_pw2 = args.in[12], *b_b_pw2 = args.in[13];
    const float *ffn_norm = args.in[14], *ffn_w_gate = args.in[15], *ffn_w_up = args.in[16], *ffn_w_down = args.in[17], *final_norm = args.in[18];
    float* out = args.out;
    float* STATS = (float*)(ws + WS_STATS);
    bf16 *Win_t = (bf16*)(ws + WS_WIN), *Wout_t = (bf16*)(ws + WS_WOUT), *Wpw1_t = (bf16*)(ws + WS_PW1), *Wpw2_t = (bf16*)(ws + WS_PW2);
    bf16 *XB = (bf16*)(ws + WS_XB), *BG = (bf16*)(ws + WS_BG), *CV = (bf16*)(ws + WS_CV), *Y = (bf16*)(ws + WS_Y), *GU = (bf16*)(ws + WS_GU);
    const int lo = args.ph_lo, hi = args.ph_hi;
#if !MK_PER_PHASE
    volatile LAS unsigned* bst = (volatile LAS unsigned*)(lds + RING_BYTES);
    if (tid < 4) bst[tid] = 0u;
    __syncthreads();
    XcdBarrier bar; bar.bar = (unsigned*)ws; bar.x = xb_xcc_id(); bar.st = bst;
    if (tid == 0) bst[2] = xb_add(&bar.bar[XB_XCNT(bar.x)], 1u);
    if (lo < 0) cg::this_grid().sync();
#endif
#define IN(k) (lo <= (k) && (k) < hi)
#if MK_PER_PHASE
#define XLOCAL() false
#define VBLK() bid
#define CVID() bid
#else
#define XLOCAL() ((__builtin_amdgcn_readfirstlane(bst[3]) >> 16) != 0)
#define VBLK() ((int)((__builtin_amdgcn_readfirstlane(bst[3]) >> 16) ? (__builtin_amdgcn_readfirstlane(bst[3]) & 0xffffu) : (unsigned)bid))
#define CVID() ((int)((__builtin_amdgcn_readfirstlane(bst[3]) >> 16) ? ((__builtin_amdgcn_readfirstlane(bst[3]) & 31u) * 8u + ((__builtin_amdgcn_readfirstlane(bst[3]) & 0xffffu) >> 5)) : (unsigned)bid))
#endif
#if MK_PER_PHASE
#define SEAM(k) do { } while (0)
#else
#define SEAM(k) do { if (IN(k) && IN((k) + 1)) { xcd_barrier(bar, XLOCAL()); } } while (0)
#endif

    if (IN(0)) {
        LAS float* scr = (LAS float*)(lds + wave * 16384);
        const int gw = bid * NWAVES + wave, NGW = G * NWAVES;
        constexpr int I_IN = 16 * 96, I_SQ = 16 * 32, I_PW1 = 16 * 64, I_GU = 16 * 88, I_DN = 44 * 32;
        constexpr int NITEMS = I_IN + 2 * I_SQ + I_PW1 + 4 * I_GU + 2 * I_DN;
        for (int it = gw; it < NITEMS; it += NGW) {
            int r = it;
            if (r < I_IN) { const int kb = r / 96, n0 = 32 * (r % 96); const int dr = n0 < 1024 ? 2048 + n0 : (n0 < 2048 ? inter128(n0 - 1024, 0) : inter128(n0 - 2048, 1));
                p0_transpose_item(a_w_in, D, 3 * D, a_norm, Win_t, kb, n0, dr, scr, lane); continue; } r -= I_IN;
            if (r < I_SQ) { const int kb = r / 32, n0 = 32 * (r % 32); p0_transpose_item(a_w_out, D, D, nullptr, Wout_t, kb, n0, n0, scr, lane); continue; } r -= I_SQ;
            if (r < I_SQ) { const int kb = r / 32, n0 = 32 * (r % 32); p0_transpose_item(b_w_pw2, D, D, nullptr, Wpw2_t, kb, n0, n0, scr, lane); continue; } r -= I_SQ;
            if (r < I_PW1) { const int kb = r / 64, n0 = 32 * (r % 64); const int dr = n0 < 1024 ? inter128(n0, 0) : inter128(n0 - 1024, 1);
                p0_transpose_item(b_w_pw1, D, 2 * D, b_norm, Wpw1_t, kb, n0, dr, scr, lane); continue; } r -= I_PW1;
            if (r < 4 * I_GU) { const int q = r / I_GU, rr = r % I_GU, layer = q >> 1, hsel = q & 1; const int kb = rr / 88, n0 = 32 * (rr % 88);
                const float* W = (hsel ? ffn_w_up : ffn_w_gate) + (size_t)layer * D * FF; bf16* WT = (bf16*)(ws + (layer ? WS_WGU1 : WS_WGU0));
                p0_transpose_item(W, D, FF, ffn_norm + layer * D, WT, kb, n0, inter128(n0, hsel), scr, lane); continue; } r -= 4 * I_GU;
            { const int layer = r / I_DN, rr = r % I_DN; const int kb = rr / 32, n0 = 32 * (rr % 32);
                p0_transpose_item(ffn_w_down + (size_t)layer * FF * D, FF, D, nullptr, (bf16*)(ws + (layer ? WS_WDN1 : WS_WDN0)), kb, n0, n0, scr, lane); }
        }
        for (int m = gw; m < M; m += NGW) {
            const GAS f32x4* xr = (const GAS f32x4*)(x + (size_t)m * D) + lane; f32x4 v[4]; float s = 0.f;
#pragma unroll
            for (int j = 0; j < 4; ++j) { v[j] = __builtin_nontemporal_load(xr + 64 * j); s += (v[j].x * v[j].x + v[j].y * v[j].y) + (v[j].z * v[j].z + v[j].w * v[j].w); }
            s = wave_sum(s);
            GAS v2u* o8 = (GAS v2u*)(XB + (size_t)m * D) + lane;
#pragma unroll
            for (int j = 0; j < 4; ++j) { v2u o; o.x = pk2(v[j].x, v[j].y); o.y = pk2(v[j].z, v[j].w); __builtin_nontemporal_store(o, o8 + 64 * j); }
            if (lane == 0) *(GAS f32x4*)(STATS + (size_t)m * pg8::NSTAT) = (f32x4){s, 0.f, 0.f, 0.f};
        }
    }
    SEAM(0);
#if !MK_PER_PHASE
    if (IN(0) && IN(1)) {
        if (tid == 0) { unsigned ok = (G == 256) ? 1u : 0u, npop = 0u, xi = 0u;
            for (unsigned j = 0; j < 16; ++j) { const unsigned c = xb_ld(&bar.bar[XB_XCNT(j)]); if (c) { ok &= (c == 32u) ? 1u : 0u; ++npop; if (j < bar.x) ++xi; } }
            ok &= (npop == 8u) ? 1u : 0u;
            bst[3] = ok ? (0x10000u | (xi * 32u + bst[2])) : 0u; }
        __syncthreads();
    }
#endif
    if (IN(1)) {
        pg8::Gemm g{XB, Win_t, M, 3 * D, D}; pg8::StaticOrder S; S.init(M, 3 * D, G, CVID());
        FILL_RSL(S); pg8::EpiPair<2> E{CV, D, BG, (const LAS float*)(lds + RSL_OFF), nullptr};
        pg8::gemm_phase<pg8::EpiPair<2>, pg8::StaticOrder, true, true>(lds, g, S, E);
    }
    SEAM(1);
    if (IN(2)) {
        const int cg8 = tid & 127, sub = tid >> 7;
        float w0[8], w1[8], w2[8];
#pragma unroll
        for (int e = 0; e < 8; ++e) { w0[e] = a_conv[8 * cg8 + e]; w1[e] = a_conv[D + 8 * cg8 + e]; w2[e] = a_conv[2 * D + 8 * cg8 + e]; }
        constexpr int CH = 32;
        for (int chunk = VBLK() * 4 + sub; chunk < M / CH; chunk += G * 4) {
            const int t0 = chunk * CH; const bool first = (t0 & (SEQ - 1)) == 0;
            const GAS v4u* cvp = (const GAS v4u*)(CV + (size_t)t0 * D + 8 * cg8); const GAS v4u* bgp = (const GAS v4u*)(BG + (size_t)t0 * D + 8 * cg8); GAS v4u* yp = (GAS v4u*)(Y + (size_t)t0 * D + 8 * cg8);
            float p2[8], p1[8];
            { v4u a = (v4u){0u, 0u, 0u, 0u}, b = a; if (!first) { a = cvp[-2 * (D / 8)]; b = cvp[-1 * (D / 8)]; }
#pragma unroll
              for (int e = 0; e < 4; ++e) { p2[2 * e] = bf_lo(a[e]); p2[2 * e + 1] = bf_hi(a[e]); p1[2 * e] = bf_lo(b[e]); p1[2 * e + 1] = bf_hi(b[e]); } }
#pragma unroll 8
            for (int t = 0; t < CH; ++t) {
                const v4u c = __builtin_nontemporal_load(cvp + t * (D / 8)), bgv = __builtin_nontemporal_load(bgp + t * (D / 8)); float cur[8], o[8];
#pragma unroll
                for (int e = 0; e < 4; ++e) { cur[2 * e] = bf_lo(c[e]); cur[2 * e + 1] = bf_hi(c[e]); }
#pragma unroll
                for (int e = 0; e < 4; ++e) { o[2 * e] = bf_lo(bgv[e]) * (w0[2 * e] * p2[2 * e] + w1[2 * e] * p1[2 * e] + w2[2 * e] * cur[2 * e]);
                                              o[2 * e + 1] = bf_hi(bgv[e]) * (w0[2 * e + 1] * p2[2 * e + 1] + w1[2 * e + 1] * p1[2 * e + 1] + w2[2 * e + 1] * cur[2 * e + 1]); }
                v4u ov; ov.x = pk2(o[0], o[1]); ov.y = pk2(o[2], o[3]); ov.z = pk2(o[4], o[5]); ov.w = pk2(o[6], o[7]);
                yp[t * (D / 8)] = ov;
#pragma unroll
                for (int e = 0; e < 8; ++e) { p2[e] = p1[e]; p1[e] = cur[e]; }
            }
        }
    }
    SEAM(2);
    if (IN(3)) {
        pg8::Gemm g{Y, Wout_t, M, D, D}; pg8::StaticOrder S; S.init(M, D, G, CVID());
        pg8::EpiRes E{XB, STATS, nullptr, (LAS float*)(lds + RSL_OFF)};
        pg8::gemm_phase<pg8::EpiRes, pg8::StaticOrder, true, true>(lds, g, S, E);
    }
    SEAM(3);
    if (IN(4)) {
        pg8::Gemm g{XB, (const bf16*)(ws + WS_WGU0), M, 2 * FF, D}; pg8::StaticOrder S; S.init(M, 2 * FF, G, CVID());
        FILL_RSL(S); pg8::EpiPair<0> E{GU, FF, nullptr, (const LAS float*)(lds + RSL_OFF), nullptr};
        pg8::gemm_phase<pg8::EpiPair<0>, pg8::StaticOrder, true, true>(lds, g, S, E);
    }
    SEAM(4);
    if (IN(5)) {
        pg8::Gemm g{GU, (const bf16*)(ws + WS_WDN0), M, D, FF}; pg8::StaticOrder S; S.init(M, D, G, CVID());
        pg8::EpiRes E{XB, STATS, nullptr, (LAS float*)(lds + RSL_OFF)};
        pg8::gemm_phase<pg8::EpiRes, pg8::StaticOrder, true, true>(lds, g, S, E);
    }
    SEAM(5);
    if (IN(6)) {
        pg8::Gemm g{XB, Wpw1_t, M, 2 * D, D}; pg8::StaticOrder S; S.init(M, 2 * D, G, CVID());
        FILL_RSL(S); pg8::EpiPair<1> E{BG, D, nullptr, (const LAS float*)(lds + RSL_OFF), b_b_pw1};
        pg8::gemm_phase<pg8::EpiPair<1>, pg8::StaticOrder, true, true>(lds, g, S, E);
    }
    SEAM(6);
    if (IN(7)) {
        const int c0 = 2 * tid;
        f32x2 w[KCONF];
#pragma unroll
        for (int k = 0; k < KCONF; ++k) w[k] = *(const f32x2*)(b_conv + k * D + c0);
        const f32x2 cb = *(const f32x2*)(b_b_conv + c0);
        f32x4 lng4[4], lnb4[4];
#pragma unroll
        for (int j = 0; j < 4; ++j) { lng4[j] = *(const f32x4*)(b_ln_g + 4 * lane + 256 * j); lnb4[j] = *(const f32x4*)(b_ln_b + 4 * lane + 256 * j); }
        constexpr int TT = 16, NTILE = M / TT; const int per = (NTILE + G - 1) / G, tb = VBLK() * per, te = (tb + per < NTILE) ? tb + per : NTILE, nt_ = te - tb;
        unsigned xr[30 + TT];
        if (nt_ > 0) { const int t0 = tb * TT; const bool first = (t0 & (SEQ - 1)) == 0; const GAS unsigned* src = (const GAS unsigned*)(BG + (size_t)t0 * D + c0);
#pragma unroll
            for (int s = 0; s < 30 + TT; ++s) { const bool pad = first && s < 30; const unsigned u = src[(long)(pad ? 0 : s - 30) * (D / 2)]; xr[s] = pad ? 0u : u; } }
#define P7_CONV(i_) do { f32x2 acc[TT]; \
            _Pragma("unroll") for (int t = 0; t < TT; ++t) acc[t] = cb; \
            _Pragma("unroll") for (int s = 0; s < 30 + TT; ++s) { const f32x2 xv = (f32x2){bf_lo(xr[s]), bf_hi(xr[s])}; \
                _Pragma("unroll") for (int t = (s > 30 ? s - 30 : 0); t <= (s < TT ? s : TT - 1); ++t) acc[t] += w[s - t] * xv; } \
            LAS float* Tw = (LAS float*)(lds + ((i_) & 1) * 65536); \
            _Pragma("unroll") for (int t = 0; t < TT; ++t) *(LAS f32x2*)(Tw + t * D + c0) = acc[t]; } while (0)
#define P7_LN(i_) do { const LAS float* Tr = (const LAS float*)(lds + ((i_) & 1) * 65536); const int tbase = (tb + (i_)) * TT; \
            _Pragma("unroll") for (int q = 0; q < 2; ++q) { const int t = wave * 2 + q; f32x4 v[4]; float s = 0.f, s2 = 0.f; \
                _Pragma("unroll") for (int j = 0; j < 4; ++j) { v[j] = *(const LAS f32x4*)(Tr + t * D + 4 * lane + 256 * j); s += (v[j].x + v[j].y) + (v[j].z + v[j].w); s2 += (v[j].x * v[j].x + v[j].y * v[j].y) + (v[j].z * v[j].z + v[j].w * v[j].w); } \
                const float mean = wave_sum(s) * (1.f / D); const float var = fmaxf(wave_sum(s2) * (1.f / D) - mean * mean, 0.f); \
                const float rstd = 1.f / sqrtf(var + LN_EPS); \
                GAS v2u* o8 = (GAS v2u*)(CV + (size_t)(tbase + t) * D) + lane; \
                _Pragma("unroll") for (int j = 0; j < 4; ++j) { const f32x4 gg = lng4[j], bb = lnb4[j]; \
                    f32x4 y = (v[j] - mean) * rstd * gg + bb; y.x *= sigm(y.x); y.y *= sigm(y.y); y.z *= sigm(y.z); y.w *= sigm(y.w); \
                    v2u o; o.x = pk2(y.x, y.y); o.y = pk2(y.z, y.w); o8[64 * j] = o; } } } while (0)
        for (int i = 0; i <= nt_; ++i) {
            unsigned xn[TT];
            if (i + 1 < nt_) { const GAS unsigned* src = (const GAS unsigned*)(BG + (size_t)((tb + i + 1) * TT) * D + c0);
#pragma unroll
                for (int s = 0; s < TT; ++s) xn[s] = __builtin_nontemporal_load(src + (long)s * (D / 2)); }
            else {
#pragma unroll
                for (int s = 0; s < TT; ++s) xn[s] = 0u; }
            if (i == 0) { P7_CONV(i); }
            else if (i == nt_) { P7_LN(i - 1); }
            else if (wave < 4) { P7_CONV(i); P7_LN(i - 1); }
            else { P7_LN(i - 1); P7_CONV(i); }
            __syncthreads();
            const bool nfirst = (((tb + i + 1) * TT) & (SEQ - 1)) == 0;
#pragma unroll
            for (int s = 0; s < 30; ++s) xr[s] = nfirst ? 0u : xr[s + TT];
#pragma unroll
            for (int s = 0; s < TT; ++s) xr[30 + s] = xn[s];
        }
#undef P7_CONV
#undef P7_LN
    }
    SEAM(7);
    if (IN(8)) {
        pg8::Gemm g{CV, Wpw2_t, M, D, D}; pg8::StaticOrder S; S.init(M, D, G, CVID());
        pg8::EpiRes E{XB, STATS, b_b_pw2, (LAS float*)(lds + RSL_OFF)};
        pg8::gemm_phase<pg8::EpiRes, pg8::StaticOrder, true, true>(lds, g, S, E);
    }
    SEAM(8);
    if (IN(9)) {
        pg8::Gemm g{XB, (const bf16*)(ws + WS_WGU1), M, 2 * FF, D}; pg8::StaticOrder S; S.init(M, 2 * FF, G, CVID());
        FILL_RSL(S); pg8::EpiPair<0> E{GU, FF, nullptr, (const LAS float*)(lds + RSL_OFF), nullptr};
        pg8::gemm_phase<pg8::EpiPair<0>, pg8::StaticOrder, true, true>(lds, g, S, E);
    }
    SEAM(9);
    if (IN(10)) {
        pg8::Gemm g{GU, (const bf16*)(ws + WS_WDN1), M, D, FF}; pg8::StaticOrder S; S.init(M, D, G, CVID());
        pg8::EpiRes E{XB, STATS, nullptr, (LAS float*)(lds + RSL_OFF)};
        pg8::gemm_phase<pg8::EpiRes, pg8::StaticOrder, true, true>(lds, g, S, E);
    }
    SEAM(10);
    if (IN(11)) {
        const int gw = bid * NWAVES + wave, NGW = G * NWAVES;
        f32x4 gn[4];
#pragma unroll
        for (int j = 0; j < 4; ++j) gn[j] = *(const f32x4*)(final_norm + 4 * lane + 256 * j);
        const int vblk11 = VBLK();
        for (int mi = 0; mi < (M / 128 + G - 1) / G * 16; ++mi) { const int blk_ = vblk11 + (mi >> 4) * G; if (blk_ >= M / 128) break; const int m = blk_ * 128 + wave * 16 + (mi & 15);
            const GAS v2u* hr = (const GAS v2u*)(XB + (size_t)m * D) + lane; v2u hv[4];
#pragma unroll
            for (int j = 0; j < 4; ++j) hv[j] = __builtin_nontemporal_load(hr + 64 * j);
            float s = lane < pg8::NSTAT ? STATS[(size_t)m * pg8::NSTAT + lane] : 0.f;
            s += __shfl_xor(s, 1); s += __shfl_xor(s, 2);
            const float r = 1.f / sqrtf(__shfl(s, 0) * (1.f / D) + RMS_EPS);
            GAS f32x4* orow = (GAS f32x4*)(out + (size_t)m * D) + lane;
#pragma unroll
            for (int j = 0; j < 4; ++j) { const f32x4 v = (f32x4){bf_lo(hv[j].x), bf_hi(hv[j].x), bf_lo(hv[j].y), bf_hi(hv[j].y)}; __builtin_nontemporal_store(v * r * gn[j], orow + 64 * j); }
        }
    }
#undef IN
#undef SEAM
}

extern "C" void kernel_launch(void* const* d_in, const int* in_sizes, int n_in, void* d_out, int out_size, void* d_ws, size_t ws_size, hipStream_t stream) {
    static int grid = 0;
    if (grid == 0) {
        if (n_in != 19 || in_sizes[0] != M * D || out_size != M * D || ws_size < WS_END) { fprintf(stderr, "kernel_launch: shape/workspace mismatch: n_in %d in0 %d out %d ws %zu (need %zu); nothing launched\n", n_in, n_in > 0 ? in_sizes[0] : -1, out_size, ws_size, (size_t)WS_END); grid = -1; return; }
        int dev = 0, cus = 0, per_cu = 0;
        if (hipGetDevice(&dev) != hipSuccess || hipDeviceGetAttribute(&cus, hipDeviceAttributeMultiprocessorCount, dev) != hipSuccess) { fprintf(stderr, "kernel_launch: device query failed\n"); grid = -1; return; }
        if (hipFuncSetAttribute((const void*)trunk_fwd, hipFuncAttributeMaxDynamicSharedMemorySize, LDS_BYTES) != hipSuccess) { fprintf(stderr, "kernel_launch: hipFuncSetAttribute failed\n"); grid = -1; return; }
        if (hipOccupancyMaxActiveBlocksPerMultiprocessor(&per_cu, (const void*)trunk_fwd, NTHR, LDS_BYTES) != hipSuccess || per_cu < 1) { fprintf(stderr, "kernel_launch: occupancy query says %d blocks/CU; using 1\n", per_cu); per_cu = 1; }
        (void)hipGetLastError();
        grid = cus * per_cu;
    }
    if (grid < 0) return;
    Args a{};
    for (int i = 0; i < 19; ++i) a.in[i] = (const float*)d_in[i];
    a.out = (float*)d_out; a.ws = (unsigned char*)d_ws;
#if MK_PER_PHASE
    for (int p = 0; p < NPHASE; ++p) { a.ph_lo = p; a.ph_hi = p + 1; hipLaunchKernelGGL(trunk_fwd, dim3(grid), dim3(NTHR), LDS_BYTES, stream, a); }
#else
    a.ph_lo = 0; a.ph_hi = NPHASE;
    if (hipMemsetAsync(d_ws, 0, 16384, stream) != hipSuccess) { fprintf(stderr, "kernel_launch: memset of the barrier words failed\n"); return; }
    void* kargs[] = {&a};
    hipError_t e = hipLaunchCooperativeKernel((const void*)trunk_fwd, dim3(grid), dim3(NTHR), kargs, LDS_BYTES, stream);
    if (e != hipSuccess) fprintf(stderr, "kernel_launch: cooperative launch failed: %s (grid %d)\n", hipGetErrorString(e), grid);
#if MK_PROBE_PHASE >= 0
    a.ph_lo = MK_PROBE_PHASE; a.ph_hi = MK_PROBE_PHASE + 1; hipLaunchKernelGGL(trunk_fwd, dim3(grid), dim3(NTHR), LDS_BYTES, stream, a);
#endif
#endif
}
```

```cpp
#include <hip/hip_runtime.h>
#include <hip/hip_cooperative_groups.h>
#include <cstdio>
#include <cstdint>
namespace cg = cooperative_groups;
#ifndef MK_PROBE_PHASE
#define MK_PROBE_PHASE -1
#endif
#ifndef MK_PER_PHASE
#define MK_PER_PHASE 0
#endif
namespace pg8 {
#define PG8_LAS __attribute__((address_space(3)))
typedef unsigned short bf16_t;
typedef short bf16x8 __attribute__((ext_vector_type(8)));
typedef float f32x4 __attribute__((ext_vector_type(4)));
typedef unsigned u32x4 __attribute__((ext_vector_type(4)));
constexpr int BM = 256, BK = 64, HALF = 128, HTB = HALF * BK * 2  , STAGE_BYTES = 8 * HTB, NXCD = 8, WGM = 8;

__host__ __device__ __forceinline__ int lds_byte(int r, int c) { const int st = (r >> 4) * 2 + (c >> 5), rr = r & 15, cc = c & 31, ob = rr * 64 + cc * 2; return st * 1024 + (ob ^ (((ob >> 9) & 1) << 5)); }
__host__ __device__ __forceinline__ void stage_rc(int b, int& R, int& C) { const int st = b / 1024, sb = b % 1024, swz = sb ^ (((sb >> 9) & 1) << 5); R = (st >> 1) * 16 + swz / 64; C = (st & 1) * 32 + (swz % 64) / 2; }
__host__ __device__ __forceinline__ int perm32(int rho) { const int n = rho >> 4, i = rho & 15; return 8 * (i >> 2) + 4 * n + (i & 3); }

struct Unit { int pm, pn; };
struct Gemm { const bf16_t* A; const bf16_t* Bt; int M, N, K; };

struct StaticOrder {
    int nM, nN, nwg, G, c;
    __host__ __device__ void init(int M, int N, int G_, int c_) { nM = M / BM; nN = N / BM; nwg = nM * nN; G = G_; c = c_; }
    __host__ __device__ bool next(int i, Unit& u) const {
        const long L = (long)i * G + c; if (L >= nwg) return false;
        int wgid = (int)L; { const int q = nwg / NXCD, r = nwg % NXCD, xcd = wgid % NXCD, off = wgid / NXCD; wgid = (xcd < r ? xcd * (q + 1) : r * (q + 1) + (xcd - r) * q) + off; }
        const int nig = WGM * nN, gid = wgid / nig, fm = gid * WGM, gsz = (nM - fm) < WGM ? (nM - fm) : WGM;
        u.pm = fm + ((wgid % nig) % gsz); u.pn = (wgid % nig) / gsz; return true;
    }
    __device__ __forceinline__ void a_ready(const Unit&) const {}
    __device__ __forceinline__ void done(const Unit&) const {}
};

__device__ __forceinline__ unsigned cvt_pk_bf16(float lo, float hi) { unsigned r; asm volatile("v_cvt_pk_bf16_f32 %0, %1, %2" : "=v"(r) : "v"(lo), "v"(hi)); return r; }
typedef float f32x2 __attribute__((ext_vector_type(2)));
__device__ __forceinline__ float sigmoid_f(float x) { return __builtin_amdgcn_rcpf(1.0f + __builtin_amdgcn_exp2f(-1.4426950408889634f * x)); }
constexpr int NSTAT = 4;
__device__ __forceinline__ void load_rscale(const float* stats, int row0, int fq, float (&rs)[2][4]) {
#pragma unroll
    for (int ai = 0; ai < 2; ++ai)
#pragma unroll
        for (int m = 0; m < 4; ++m) {
            const f32x4 p = *(const f32x4*)(stats + (size_t)(row0 + ai * HALF + m * 16) * NSTAT + fq * 4);
            float s = (p[0] + p[1]) + (p[2] + p[3]); s += __shfl_xor(s, 16); s += __shfl_xor(s, 32);
            rs[ai][m] = 1.0f / sqrtf(s * (1.0f / 1024.0f) + 1e-6f);
        }
}
__device__ __forceinline__ u32x4 pack8(const f32x4 v0, const f32x4 v1) { u32x4 w; w.x = cvt_pk_bf16(v0[0], v0[1]); w.y = cvt_pk_bf16(v0[2], v0[3]); w.z = cvt_pk_bf16(v1[0], v1[1]); w.w = cvt_pk_bf16(v1[2], v1[3]); return w; }
template <int MODE> struct EpiPair {
    static constexpr bool PERM = true, AFTER_DRAIN = false;
    bf16_t* O; int ldc; bf16_t* O2; const PG8_LAS float* rsl; const float* bias;
    __device__ __forceinline__ void operator()(const f32x4 (&acc)[2][2][4][2], const Unit& u, int ui, int wr, int wc, int fr, int fq) const {
        const int row0 = u.pm * BM + wr * 64 + fr, cw = wc * 32 + 8 * fq;
        float rs[2][4];
#pragma unroll
        for (int ai = 0; ai < 2; ++ai)
#pragma unroll
            for (int m = 0; m < 4; ++m) rs[ai][m] = rsl[ui * BM + ai * HALF + wr * 64 + m * 16 + fr];
        if (MODE == 2 && u.pn >= 8) {
#pragma unroll
            for (int ai = 0; ai < 2; ++ai)
#pragma unroll
                for (int m = 0; m < 4; ++m) { const float r = rs[ai][m]; bf16_t* rowp = O2 + (size_t)(row0 + ai * HALF + m * 16) * 1024 + (u.pn - 8) * BM + cw;
#pragma unroll
                    for (int bj = 0; bj < 2; ++bj) *(u32x4*)(rowp + bj * HALF) = pack8(acc[ai][bj][m][0] * r, acc[ai][bj][m][1] * r); }
            return;
        }
        f32x4 bp[2], bq[2];
#pragma unroll
        for (int n = 0; n < 2; ++n) { bp[n] = (f32x4){0.f, 0.f, 0.f, 0.f}; bq[n] = bp[n]; if (MODE == 1) { bp[n] = *(const f32x4*)(bias + u.pn * HALF + cw + 4 * n); bq[n] = *(const f32x4*)(bias + 1024 + u.pn * HALF + cw + 4 * n); } }
#pragma unroll
        for (int ai = 0; ai < 2; ++ai)
#pragma unroll
            for (int m = 0; m < 4; ++m) { const float r = rs[ai][m], r2 = r * r, rc = -1.4426950408889634f * r; bf16_t* rowp = O + (size_t)(row0 + ai * HALF + m * 16) * ldc + u.pn * HALF + cw;
                f32x4 o[2];
#pragma unroll
                for (int n = 0; n < 2; ++n) { const f32x4 ap = acc[ai][0][m][n], aq = acc[ai][1][m][n];
                    if (MODE == 0) { const f32x4 t = ap * rc; f32x4 d; d[0] = __builtin_amdgcn_exp2f(t[0]); d[1] = __builtin_amdgcn_exp2f(t[1]); d[2] = __builtin_amdgcn_exp2f(t[2]); d[3] = __builtin_amdgcn_exp2f(t[3]);
                        d = d + 1.0f; f32x4 s; s[0] = __builtin_amdgcn_rcpf(d[0]); s[1] = __builtin_amdgcn_rcpf(d[1]); s[2] = __builtin_amdgcn_rcpf(d[2]); s[3] = __builtin_amdgcn_rcpf(d[3]);
                        o[n] = (ap * aq) * (s * r2); }
                    else if (MODE == 1) { const f32x4 p = ap * r + bp[n], q = aq * r + bq[n], t = q * (-1.4426950408889634f); f32x4 d; d[0] = __builtin_amdgcn_exp2f(t[0]); d[1] = __builtin_amdgcn_exp2f(t[1]); d[2] = __builtin_amdgcn_exp2f(t[2]); d[3] = __builtin_amdgcn_exp2f(t[3]);
                        d = d + 1.0f; f32x4 s; s[0] = __builtin_amdgcn_rcpf(d[0]); s[1] = __builtin_amdgcn_rcpf(d[1]); s[2] = __builtin_amdgcn_rcpf(d[2]); s[3] = __builtin_amdgcn_rcpf(d[3]);
                        o[n] = p * s; }
                    else o[n] = (ap * aq) * r2; }
                if (MODE != 0) *(u32x4*)rowp = pack8(o[0], o[1]); else __builtin_nontemporal_store(pack8(o[0], o[1]), (u32x4*)rowp); }
    }
};
struct EpiRes {
    static constexpr bool PERM = true, AFTER_DRAIN = false;
    bf16_t* xb; float* stats; const float* bias; PG8_LAS float* xl;
    __device__ __forceinline__ void operator()(const f32x4 (&acc)[2][2][4][2], const Unit& u, int ui, int wr, int wc, int fr, int fq) const {
        const int row0 = u.pm * BM + wr * 64 + fr, col0 = u.pn * BM + wc * 32 + 8 * fq;
        u32x4 b[2][2][2];
#define RES_LOAD(g) do { _Pragma("unroll") for (int mm = 0; mm < 2; ++mm) _Pragma("unroll") for (int bj = 0; bj < 2; ++bj) \
            b[(g) & 1][mm][bj] = *(const u32x4*)(xb + (size_t)(row0 + ((g) >> 1) * HALF + (2 * ((g) & 1) + mm) * 16) * 1024 + col0 + bj * HALF); } while (0)
        RES_LOAD(0); RES_LOAD(1);
        asm volatile("" ::: "memory");
#pragma unroll
        for (int g = 0; g < 4; ++g) {
#pragma unroll
            for (int mm = 0; mm < 2; ++mm) { const int ai = g >> 1, m = 2 * (g & 1) + mm; const int row = row0 + ai * HALF + m * 16; bf16_t* p = xb + (size_t)row * 1024 + col0; float ss = 0.f;
#pragma unroll
                for (int bj = 0; bj < 2; ++bj) { const u32x4 bb = b[g & 1][mm][bj];
                    const f32x4 b0 = (f32x4){__builtin_bit_cast(float, bb.x << 16), __builtin_bit_cast(float, bb.x & 0xffff0000u), __builtin_bit_cast(float, bb.y << 16), __builtin_bit_cast(float, bb.y & 0xffff0000u)};
                    const f32x4 b1 = (f32x4){__builtin_bit_cast(float, bb.z << 16), __builtin_bit_cast(float, bb.z & 0xffff0000u), __builtin_bit_cast(float, bb.w << 16), __builtin_bit_cast(float, bb.w & 0xffff0000u)};
                    f32x4 v0 = b0 + acc[ai][bj][m][0], v1 = b1 + acc[ai][bj][m][1];
                    if (bias) { v0 += *(const f32x4*)(bias + col0 + bj * HALF); v1 += *(const f32x4*)(bias + col0 + bj * HALF + 4); }
                    ss += (v0[0] * v0[0] + v0[1] * v0[1]) + (v0[2] * v0[2] + v0[3] * v0[3]) + (v1[0] * v1[0] + v1[1] * v1[1]) + (v1[2] * v1[2] + v1[3] * v1[3]);
                    *(u32x4*)(p + bj * HALF) = pack8(v0, v1); }
                ss += __shfl_xor(ss, 16); ss += __shfl_xor(ss, 32); if (fq == 0) xl[wc * BM + ai * HALF + wr * 64 + m * 16 + fr] = ss; }
            asm volatile("" ::: "memory");
            if (g + 2 < 4) { RES_LOAD(g + 2); asm volatile("" ::: "memory"); }
        }
#undef RES_LOAD
        asm volatile("s_waitcnt lgkmcnt(0)" ::: "memory"); __builtin_amdgcn_s_barrier(); asm volatile("" ::: "memory");
        if (threadIdx.x < 256) { const int r = threadIdx.x; stats[(size_t)(u.pm * BM + r) * NSTAT + u.pn] = (xl[r] + xl[BM + r]) + (xl[2 * BM + r] + xl[3 * BM + r]); }
    }
};
template <class Epi, class Sched, bool ALIGN_EPI = false, bool SP2 = false>
__device__ __forceinline__ void gemm_phase(PG8_LAS unsigned char* lds, const Gemm g, const Sched& S, const Epi& E) {
    const int tid = threadIdx.x, wid = __builtin_amdgcn_readfirstlane(tid >> 6), lane = tid & 63, wr = wid >> 2, wc = wid & 3, fr = lane & 15, fq = lane >> 4;
    const int K = g.K, nt = K / BK;
    unsigned voffA[2], voffB[2];
#pragma unroll
    for (int i = 0; i < 2; ++i) { int R, C; stage_rc(tid * 16 + i * 8192, R, C); const int Rb = Epi::PERM ? ((R & ~31) + perm32(R & 31)) : R;
        voffA[i] = (unsigned)(R * K + C) * 2u; voffB[i] = (unsigned)(Rb * K + C) * 2u; }
    const size_t kstep = (size_t)(BK * 2);
    const size_t hstep = (size_t)HALF * K * 2;
    const size_t tstep = 2 * hstep;
    const unsigned ldsw = (unsigned)wid * 1024u;
    const int aoff = lds_byte(wr * 64 + fr, fq * 8), boff = lds_byte(wc * 32 + fr, fq * 8);
#define PG8_SA(b, h) (((b) * 2 + (h)) * HTB)
#define PG8_SB(b, h) ((4 + (b) * 2 + (h)) * HTB)
#define PG8_STAGE(bufoff, gbase, voff) do { _Pragma("unroll") for (int _i = 0; _i < 2; ++_i) \
        __builtin_amdgcn_global_load_lds((const unsigned*)((const char*)(gbase) + (voff)[_i]), (PG8_LAS unsigned*)(lds + (bufoff) + ldsw + _i * 8192), 16, 0, 0); } while (0)
#define PG8_LDA(dst, b, h) do { _Pragma("unroll") for (int m = 0; m < 4; ++m) _Pragma("unroll") for (int k = 0; k < 2; ++k) dst[m][k] = *(const PG8_LAS bf16x8*)(lds + PG8_SA(b, h) + aoff + m * 2048 + k * 1024); } while (0)
#define PG8_LDB(dst, b, h) do { _Pragma("unroll") for (int n = 0; n < 2; ++n) _Pragma("unroll") for (int k = 0; k < 2; ++k) dst[n][k] = *(const PG8_LAS bf16x8*)(lds + PG8_SB(b, h) + boff + n * 2048 + k * 1024); } while (0)
#define PG8_MMA(ai, bj, At, Bt) do { __builtin_amdgcn_s_setprio(1); _Pragma("unroll") for (int m = 0; m < 4; ++m) _Pragma("unroll") for (int n = 0; n < 2; ++n) _Pragma("unroll") for (int k = 0; k < 2; ++k) \
        acc[ai][bj][m][n] = __builtin_amdgcn_mfma_f32_16x16x32_bf16(Bt[n][k], At[m][k], acc[ai][bj][m][n], 0, 0, 0); __builtin_amdgcn_s_setprio(0); } while (0)
#define PG8_WAIT_V(n) asm volatile("s_waitcnt vmcnt(" #n ")" ::: "memory")
#define PG8_WAIT_L(n) asm volatile("s_waitcnt lgkmcnt(" #n ")" ::: "memory")
#define PG8_BAR __builtin_amdgcn_s_barrier()
#define PG8_SCHED __builtin_amdgcn_sched_barrier(0)
    Unit cur, nxt; int ui = 0;
    if (!S.next(0, cur)) return;
    f32x4 acc[2][2][4][2];
#pragma unroll
    for (int a = 0; a < 2; ++a)
#pragma unroll
        for (int b = 0; b < 2; ++b)
#pragma unroll
            for (int m = 0; m < 4; ++m)
#pragma unroll
                for (int n = 0; n < 2; ++n) acc[a][b][m][n] = (f32x4){0.f, 0.f, 0.f, 0.f};
    bf16x8 At[4][2], B0[2][2], B1[2][2];
    const char* cA = (const char*)g.A + (size_t)cur.pm * tstep; const char* cB = (const char*)g.Bt + (size_t)cur.pn * tstep;
    S.a_ready(cur);
    if constexpr (SP2) {
        PG8_STAGE(PG8_SB(0, 0), cB, voffB); PG8_STAGE(PG8_SB(0, 1), cB + hstep, voffB); PG8_STAGE(PG8_SA(0, 0), cA, voffA); PG8_STAGE(PG8_SA(0, 1), cA + hstep, voffA);
        if (wr == 1) PG8_BAR;
        PG8_WAIT_V(2); PG8_BAR;
        PG8_STAGE(PG8_SB(1, 0), cB + kstep, voffB); PG8_STAGE(PG8_SA(1, 0), cA + kstep, voffA); PG8_STAGE(PG8_SB(1, 1), cB + hstep + kstep, voffB);
        PG8_WAIT_V(6); PG8_BAR;
    } else {
        PG8_STAGE(PG8_SB(0, 0), cB, voffB); PG8_STAGE(PG8_SA(0, 0), cA, voffA); PG8_STAGE(PG8_SB(0, 1), cB + hstep, voffB); PG8_STAGE(PG8_SA(0, 1), cA + hstep, voffA);
        if (wr == 1) PG8_BAR;
        PG8_WAIT_V(4); PG8_BAR;
        PG8_STAGE(PG8_SB(1, 0), cB + kstep, voffB); PG8_STAGE(PG8_SA(1, 0), cA + kstep, voffA); PG8_STAGE(PG8_SB(1, 1), cB + hstep + kstep, voffB);
        PG8_WAIT_V(6); PG8_BAR;
    }
    for (;;) {
        const bool has_next = S.next(ui + 1, nxt);
        const char* nA = has_next ? (const char*)g.A + (size_t)nxt.pm * tstep : cA; const char* nB = has_next ? (const char*)g.Bt + (size_t)nxt.pn * tstep : cB;
        for (int t = 0; t < nt; t += 2) {
            const bool last = (t == nt - 2);
            const char* a1 = cA + (size_t)(t + 1) * kstep;
            const char* a2 = last ? nA : cA + (size_t)(t + 2) * kstep; const char* b2 = last ? nB : cB + (size_t)(t + 2) * kstep;
            const char* a3 = a2 + kstep; const char* b3 = b2 + kstep;
            if (last && has_next) S.a_ready(nxt);
            if constexpr (SP2) {
            PG8_LDB(B0, 0, 0); PG8_LDB(B1, 0, 1); PG8_SCHED; PG8_LDA(At, 0, 0); PG8_STAGE(PG8_SA(1, 1), a1 + hstep, voffA);
            PG8_WAIT_V(8); PG8_WAIT_L(0); PG8_BAR; PG8_MMA(0, 0, At, B0); PG8_MMA(0, 1, At, B1); PG8_BAR; PG8_SCHED;
            PG8_LDA(At, 0, 1); PG8_STAGE(PG8_SB(0, 0), b2, voffB); PG8_STAGE(PG8_SB(0, 1), b2 + hstep, voffB); PG8_STAGE(PG8_SA(0, 0), a2, voffA);
            PG8_WAIT_V(8); PG8_WAIT_L(0); PG8_BAR; PG8_MMA(1, 0, At, B0); PG8_MMA(1, 1, At, B1); PG8_BAR; PG8_SCHED;
            PG8_LDB(B0, 1, 0); PG8_LDB(B1, 1, 1); PG8_SCHED; PG8_LDA(At, 1, 0); PG8_STAGE(PG8_SA(0, 1), a2 + hstep, voffA);
            PG8_WAIT_V(8); PG8_WAIT_L(0); PG8_BAR; PG8_MMA(0, 0, At, B0); PG8_MMA(0, 1, At, B1); PG8_BAR; PG8_SCHED;
            PG8_LDA(At, 1, 1); PG8_STAGE(PG8_SB(1, 0), b3, voffB); PG8_STAGE(PG8_SB(1, 1), b3 + hstep, voffB); PG8_STAGE(PG8_SA(1, 0), a3, voffA);
            PG8_WAIT_V(8); PG8_WAIT_L(0); PG8_BAR; PG8_MMA(1, 0, At, B0); PG8_MMA(1, 1, At, B1); PG8_BAR; PG8_SCHED;
            } else {
            PG8_LDB(B0, 0, 0); PG8_SCHED; PG8_LDA(At, 0, 0); PG8_STAGE(PG8_SA(1, 1), a1 + hstep, voffA);
            PG8_WAIT_L(8); PG8_BAR; PG8_WAIT_L(0); PG8_MMA(0, 0, At, B0); PG8_BAR; PG8_SCHED;
            PG8_LDB(B1, 0, 1); PG8_STAGE(PG8_SB(0, 0), b2, voffB);
            PG8_BAR; PG8_WAIT_L(0); PG8_MMA(0, 1, At, B1); PG8_BAR;
            PG8_LDA(At, 0, 1); PG8_STAGE(PG8_SA(0, 0), a2, voffA);
            PG8_BAR; PG8_WAIT_L(0); PG8_MMA(1, 0, At, B0); PG8_BAR; PG8_SCHED;
            PG8_STAGE(PG8_SB(0, 1), b2 + hstep, voffB);
            PG8_WAIT_V(6); PG8_BAR; PG8_MMA(1, 1, At, B1); PG8_BAR;
            PG8_LDB(B0, 1, 0); PG8_SCHED; PG8_LDA(At, 1, 0); PG8_STAGE(PG8_SA(0, 1), a2 + hstep, voffA);
            PG8_WAIT_L(8); PG8_BAR; PG8_WAIT_L(0); PG8_MMA(0, 0, At, B0); PG8_BAR; PG8_SCHED;
            PG8_LDB(B1, 1, 1); PG8_STAGE(PG8_SB(1, 0), b3, voffB);
            PG8_BAR; PG8_WAIT_L(0); PG8_MMA(0, 1, At, B1); PG8_BAR;
            PG8_LDA(At, 1, 1); PG8_STAGE(PG8_SA(1, 0), a3, voffA);
            PG8_BAR; PG8_WAIT_L(0); PG8_MMA(1, 0, At, B0); PG8_BAR; PG8_SCHED;
            PG8_STAGE(PG8_SB(1, 1), b3 + hstep, voffB);
            PG8_WAIT_V(6); PG8_BAR; PG8_MMA(1, 1, At, B1); PG8_BAR;
            }
        }
        if constexpr (ALIGN_EPI) { if (wr == 0) PG8_BAR; }
        if constexpr (!Epi::AFTER_DRAIN) { E(acc, cur, ui, wr, wc, fr, fq); S.done(cur); }
        if (!has_next) break;
#pragma unroll
        for (int a = 0; a < 2; ++a)
#pragma unroll
            for (int b = 0; b < 2; ++b)
#pragma unroll
                for (int m = 0; m < 4; ++m)
#pragma unroll
                    for (int n = 0; n < 2; ++n) acc[a][b][m][n] = (f32x4){0.f, 0.f, 0.f, 0.f};
        cur = nxt; cA = nA; cB = nB; ++ui;
        if constexpr (ALIGN_EPI) { if (wr == 1) PG8_BAR; }
    }
    PG8_WAIT_V(0);
    if constexpr (!ALIGN_EPI) { if (wr == 0) PG8_BAR; }
    PG8_BAR;
    if constexpr (Epi::AFTER_DRAIN) { E.fused(acc, cur, wr, wc, fr, fq, lds, wid, lane); S.done(cur); }
#undef PG8_SA
#undef PG8_SB
#undef PG8_STAGE
#undef PG8_LDA
#undef PG8_LDB
#undef PG8_MMA
#undef PG8_WAIT_V
#undef PG8_WAIT_L
#undef PG8_BAR
#undef PG8_SCHED
}
}

constexpr int NWAVES = 8, NTHR = NWAVES * 64;
constexpr int BATCH = 8, SEQ = 4096, D = 1024, FF = 2816, M = BATCH * SEQ;
constexpr int KCONF = 31;
constexpr float RMS_EPS = 1e-6f, LN_EPS = 1e-5f;
constexpr int NPHASE = 12;
constexpr size_t MiB = 1u << 20;
constexpr size_t WS_STATS = 1 * MiB;
constexpr size_t WS_WIN = 4 * MiB, WS_WOUT = 10 * MiB, WS_PW1 = 12 * MiB, WS_PW2 = 16 * MiB;
constexpr size_t WS_WGU0 = 18 * MiB, WS_WGU1 = 29 * MiB, WS_WDN0 = 40 * MiB, WS_WDN1 = 46 * MiB;
constexpr size_t WS_XB = 64 * MiB;
constexpr size_t WS_BG = 128 * MiB, WS_CV = 192 * MiB, WS_Y = 256 * MiB;
constexpr size_t WS_GU = 320 * MiB;
constexpr size_t WS_END = 496 * MiB;
static_assert(WS_WDN1 + (size_t)D * FF * 2 <= WS_XB && WS_WGU0 + (size_t)2 * FF * D * 2 <= WS_WGU1 && WS_WDN0 + (size_t)D * FF * 2 <= WS_WDN1 && WS_GU + (size_t)M * FF * 2 <= WS_END, "d_ws map");
constexpr int RING_BYTES = 131072;
constexpr int RSL_OFF = RING_BYTES + 4096;
constexpr int LDS_BYTES = 147456;

#define GAS __attribute__((address_space(1)))
#define LAS __attribute__((address_space(3)))
typedef unsigned short bf16;
typedef unsigned v4u __attribute__((ext_vector_type(4)));
typedef unsigned v2u __attribute__((ext_vector_type(2)));
typedef float f32x4 __attribute__((ext_vector_type(4)));
typedef float f32x2 __attribute__((ext_vector_type(2)));
#define LDS_WAIT() asm volatile("s_waitcnt lgkmcnt(0)" ::: "memory")
__device__ __forceinline__ unsigned f2bf(float f) { unsigned u = __builtin_bit_cast(unsigned, f); return (u + 0x7fffu + ((u >> 16) & 1u)) >> 16; }
__device__ __forceinline__ unsigned pk2(float lo, float hi) { return pg8::cvt_pk_bf16(lo, hi); }
__device__ __forceinline__ float bf_lo(unsigned u) { return __builtin_bit_cast(float, u << 16); }
__device__ __forceinline__ float bf_hi(unsigned u) { return __builtin_bit_cast(float, u & 0xffff0000u); }
template <int CTRL> __device__ __forceinline__ float dpp_mov(float v) { return __builtin_bit_cast(float, __builtin_amdgcn_update_dpp(0, __builtin_bit_cast(int, v), CTRL, 0xF, 0xF, false)); }
__device__ __forceinline__ float wave_sum(float v) {
    v += dpp_mov<0xB1>(v); v += dpp_mov<0x4E>(v); v += dpp_mov<0x124>(v); v += dpp_mov<0x128>(v);
    const int iv = __builtin_bit_cast(int, v);
    const float a = __builtin_bit_cast(float, __builtin_amdgcn_readlane(iv, 0)), b = __builtin_bit_cast(float, __builtin_amdgcn_readlane(iv, 16));
    const float c = __builtin_bit_cast(float, __builtin_amdgcn_readlane(iv, 32)), d = __builtin_bit_cast(float, __builtin_amdgcn_readlane(iv, 48));
    return (a + b) + (c + d);
}
__device__ __forceinline__ float sigm(float x) { return __builtin_amdgcn_rcpf(1.0f + __builtin_amdgcn_exp2f(-1.4426950408889634f * x)); }

#define XB_TMO      128
#define XB_XCNT(j)  (256  + 64 * (j))
#define XB_XSUB(j)  (1280 + 64 * (j))
#define XB_XGEN(j)  (2304 + 64 * (j))
#define XB_TOP      3328
#define XB_TOPGEN   3392
#define XCD_BAR_WORDS 3456
#define XB_SPIN_CAP (1u << 18)

__device__ __forceinline__ unsigned xb_ld(unsigned* p)              { return __hip_atomic_load(p, __ATOMIC_RELAXED, __HIP_MEMORY_SCOPE_AGENT); }
__device__ __forceinline__ unsigned xb_add(unsigned* p, unsigned v) { return __hip_atomic_fetch_add(p, v, __ATOMIC_RELAXED, __HIP_MEMORY_SCOPE_AGENT); }
__device__ __forceinline__ unsigned xb_xcc_id() { return (unsigned)__builtin_amdgcn_s_getreg((3 << 11) | 20) & 0xFu; }
#define XB_SPIN(cond, bar) do { unsigned _sp = 0; while (cond) { __builtin_amdgcn_s_sleep(1); \
    if ((++_sp & 255u) == 0u) { if (xb_ld(&(bar)[XB_TMO])) break; if (_sp > XB_SPIN_CAP) { atomicAdd(&(bar)[XB_TMO], 1u); break; } } } } while (0)

struct XcdBarrier {
    unsigned* bar; unsigned x;
    volatile LAS unsigned* st;
};

__device__ __forceinline__ XcdBarrier xcd_barrier_post(unsigned* bar, volatile LAS unsigned* st) {
    XcdBarrier b; b.bar = bar; b.x = xb_xcc_id(); b.st = st;
    if (threadIdx.x == 0) (void)xb_add(&bar[XB_XCNT(b.x)], 1u);
    return b;
}
__device__ __forceinline__ void xcd_barrier_complete(unsigned* bar, unsigned x, unsigned& nloc, unsigned& nx) {
    const unsigned G = gridDim.x * gridDim.y * gridDim.z;
    unsigned sum, cnt, mine, sp = 0u;
    for (;;) {
        sum = 0u; cnt = 0u; mine = 0u;
#pragma unroll
        for (unsigned j = 0; j < 16; ++j) { const unsigned c = xb_ld(&bar[XB_XCNT(j)]); sum += c; cnt += (c > 0u) ? 1u : 0u; mine = (j == x) ? c : mine; }
        if (sum == G) break;
        __builtin_amdgcn_s_sleep(1);
        if ((++sp & 255u) == 0u) { if (xb_ld(&bar[XB_TMO])) break; if (sp > XB_SPIN_CAP) { atomicAdd(&bar[XB_TMO], 1u); break; } }
    }
    nloc = mine > 0u ? mine : 1u; nx = cnt > 0u ? cnt : 1u;
}

__device__ __forceinline__ void xcd_barrier(const XcdBarrier& b, bool local) {
    asm volatile("s_waitcnt vmcnt(0)" ::: "memory");
    __syncthreads();
    if (threadIdx.x == 0) {
        unsigned* bar = b.bar;
        __builtin_amdgcn_s_waitcnt(0);
        unsigned nloc = b.st[0], nx = b.st[1];
        if (nloc == 0u) { xcd_barrier_complete(bar, b.x, nloc, nx); b.st[0] = nloc; b.st[1] = nx; }
        const unsigned old = xb_add(&bar[XB_XSUB(b.x)], 1u);
        const unsigned gen = old / nloc;
        if (old + 1u == (gen + 1u) * nloc) {
          if (!local) {
            __builtin_amdgcn_fence(__ATOMIC_RELEASE, "agent");
            asm volatile("s_waitcnt vmcnt(0)" ::: "memory");
            const unsigned og = xb_add(&bar[XB_TOP], 1u);
            const unsigned tg = og / nx;
            if (og + 1u == (tg + 1u) * nx) xb_add(&bar[XB_TOPGEN], 1u);
            else XB_SPIN(xb_ld(&bar[XB_TOPGEN]) == tg, bar);
          }
            __builtin_amdgcn_fence(__ATOMIC_ACQUIRE, "agent");
            xb_add(&bar[XB_XGEN(b.x)], 1u);
            asm volatile("s_waitcnt vmcnt(0)" ::: "memory");
        } else {
            XB_SPIN(xb_ld(&bar[XB_XGEN(b.x)]) == gen, bar);
            __builtin_amdgcn_fence(__ATOMIC_ACQUIRE, "agent");
            asm volatile("s_waitcnt vmcnt(0)" ::: "memory");
        }
    }
    __syncthreads();
}

__device__ __forceinline__ void p0_transpose_item(const float* W, int K, int N, const float* gain, bf16* WT, int kb, int n0, int drow0, LAS float* scr, int lane) {
    const int k0 = 64 * kb;
#pragma unroll 8
    for (int i = 0; i < 32; ++i) { const int kk = 2 * i + (lane >> 5); scr[kk * 33 + (lane & 31)] = __builtin_nontemporal_load(W + (size_t)(k0 + kk) * N + n0 + (lane & 31)); }
    LDS_WAIT(); asm volatile("" ::: "memory");
    const int c = lane & 7;
    float gk[8];
#pragma unroll
    for (int e = 0; e < 8; ++e) gk[e] = gain ? gain[k0 + 8 * c + e] : 1.0f;
#pragma unroll
    for (int j = 0; j < 4; ++j) { const int n = (lane >> 3) + 8 * j; const LAS float* s = scr + (8 * c) * 33 + n;
        v4u o; o.x = pk2(s[0 * 33] * gk[0], s[1 * 33] * gk[1]); o.y = pk2(s[2 * 33] * gk[2], s[3 * 33] * gk[3]); o.z = pk2(s[4 * 33] * gk[4], s[5 * 33] * gk[5]); o.w = pk2(s[6 * 33] * gk[6], s[7 * 33] * gk[7]);
        __builtin_nontemporal_store(o, (GAS v4u*)(WT + (size_t)(drow0 + n) * K + k0 + 8 * c)); }
    LDS_WAIT(); asm volatile("" ::: "memory");
}
__device__ __forceinline__ int inter128(int j, int h) { return 256 * (j >> 7) + 128 * h + (j & 127); }

#define FILL_RSL(S) do { LAS float* rsl_ = (LAS float*)(lds + RSL_OFF); f32x4 t_[6]; \
        _Pragma("unroll") for (int j_ = 0; j_ < 6; ++j_) { pg8::Unit u_; t_[j_] = (f32x4){1.f, 1.f, 1.f, 1.f};        \
            if (S.next((tid >> 8) + 2 * j_, u_)) t_[j_] = *(const f32x4*)(STATS + (size_t)(u_.pm * 256 + (tid & 255)) * pg8::NSTAT); } \
        _Pragma("unroll") for (int j_ = 0; j_ < 6; ++j_) rsl_[((tid >> 8) + 2 * j_) * 256 + (tid & 255)] = 1.0f / sqrtf(((t_[j_][0] + t_[j_][1]) + (t_[j_][2] + t_[j_][3])) * (1.0f / D) + RMS_EPS); \
        __syncthreads(); } while (0)
struct Args { const float* in[19]; float* out; unsigned char* ws; int ph_lo, ph_hi; };

__global__ void __launch_bounds__(NTHR, 2) trunk_fwd(Args args) {
    extern __shared__ __attribute__((aligned(16))) unsigned char lds_raw[];
    LAS unsigned char* lds = (LAS unsigned char*)lds_raw;
    const int tid = threadIdx.x, lane = tid & 63, wave = __builtin_amdgcn_readfirstlane(tid >> 6);
    const int G = gridDim.x, bid = blockIdx.x;
    unsigned char* ws = args.ws;
    const float* x = args.in[0];
    const float *a_norm = args.in[1], *a_w_in = args.in[2], *a_conv = args.in[3], *a_w_out = args.in[4];
    const float *b_norm = args.in[5], *b_w_pw1 = args.in[6], *b_b_pw1 = args.in[7], *b_conv = args.in[8], *b_b_conv = args.in[9], *b_ln_g = args.in[10], *b_ln_b = args.in[11], *b_w_pw2 = args.in[12], *b_b_pw2 = args.in[13];
    const float *ffn_norm = args.in[14], *ffn_w_gate = args.in[15], *ffn_w_up = args.in[16], *ffn_w_down = args.in[17], *final_norm = args.in[18];
    float* out = args.out;
    float* STATS = (float*)(ws + WS_STATS);
    bf16 *Win_t = (bf16*)(ws + WS_WIN), *Wout_t = (bf16*)(ws + WS_WOUT), *Wpw1_t = (bf16*)(ws + WS_PW1), *Wpw2_t = (bf16*)(ws + WS_PW2);
    bf16 *XB = (bf16*)(ws + WS_XB), *BG = (bf16*)(ws + WS_BG), *CV = (bf16*)(ws + WS_CV), *Y = (bf16*)(ws + WS_Y), *GU = (bf16*)(ws + WS_GU);
    const int lo = args.ph_lo, hi = args.ph_hi;
#if !MK_PER_PHASE
    volatile LAS unsigned* bst = (volatile LAS unsigned*)(lds + RING_BYTES);
    if (tid < 4) bst[tid] = 0u;
    __syncthreads();
    XcdBarrier bar; bar.bar = (unsigned*)ws; bar.x = xb_xcc_id(); bar.st = bst;
    if (tid == 0) bst[2] = xb_add(&bar.bar[XB_XCNT(bar.x)], 1u);
    if (lo < 0) cg::this_grid().sync();
#endif
#define IN(k) (lo <= (k) && (k) < hi)
#if MK_PER_PHASE
#define XLOCAL() false
#define VBLK() bid
#define CVID() bid
#else
#define XLOCAL() ((__builtin_amdgcn_readfirstlane(bst[3]) >> 16) != 0)
#define VBLK() ((int)((__builtin_amdgcn_readfirstlane(bst[3]) >> 16) ? (__builtin_amdgcn_readfirstlane(bst[3]) & 0xffffu) : (unsigned)bid))
#define CVID() ((int)((__builtin_amdgcn_readfirstlane(bst[3]) >> 16) ? ((__builtin_amdgcn_readfirstlane(bst[3]) & 31u) * 8u + ((__builtin_amdgcn_readfirstlane(bst[3]) & 0xffffu) >> 5)) : (unsigned)bid))
#endif
#if MK_PER_PHASE
#define SEAM(k) do { } while (0)
#else
#define SEAM(k) do { if (IN(k) && IN((k) + 1)) { xcd_barrier(bar, XLOCAL()); } } while (0)
#endif

    if (IN(0)) {
        LAS float* scr = (LAS float*)(lds + wave * 16384);
        const int gw = bid * NWAVES + wave, NGW = G * NWAVES;
        constexpr int I_IN = 16 * 96, I_SQ = 16 * 32, I_PW1 = 16 * 64, I_GU = 16 * 88, I_DN = 44 * 32;
        constexpr int NITEMS = I_IN + 2 * I_SQ + I_PW1 + 4 * I_GU + 2 * I_DN;
        for (int it = gw; it < NITEMS; it += NGW) {
            int r = it;
            if (r < I_IN) { const int kb = r / 96, n0 = 32 * (r % 96); const int dr = n0 < 1024 ? 2048 + n0 : (n0 < 2048 ? inter128(n0 - 1024, 0) : inter128(n0 - 2048, 1));
                p0_transpose_item(a_w_in, D, 3 * D, a_norm, Win_t, kb, n0, dr, scr, lane); continue; } r -= I_IN;
            if (r < I_SQ) { const int kb = r / 32, n0 = 32 * (r % 32); p0_transpose_item(a_w_out, D, D, nullptr, Wout_t, kb, n0, n0, scr, lane); continue; } r -= I_SQ;
            if (r < I_SQ) { const int kb = r / 32, n0 = 32 * (r % 32); p0_transpose_item(b_w_pw2, D, D, nullptr, Wpw2_t, kb, n0, n0, scr, lane); continue; } r -= I_SQ;
            if (r < I_PW1) { const int kb = r / 64, n0 = 32 * (r % 64); const int dr = n0 < 1024 ? inter128(n0, 0) : inter128(n0 - 1024, 1);
                p0_transpose_item(b_w_pw1, D, 2 * D, b_norm, Wpw1_t, kb, n0, dr, scr, lane); continue; } r -= I_PW1;
            if (r < 4 * I_GU) { const int q = r / I_GU, rr = r % I_GU, layer = q >> 1, hsel = q & 1; const int kb = rr / 88, n0 = 32 * (rr % 88);
                const float* W = (hsel ? ffn_w_up : ffn_w_gate) + (size_t)layer * D * FF; bf16* WT = (bf16*)(ws + (layer ? WS_WGU1 : WS_WGU0));
                p0_transpose_item(W, D, FF, ffn_norm + layer * D, WT, kb, n0, inter128(n0, hsel), scr, lane); continue; } r -= 4 * I_GU;
            { const int layer = r / I_DN, rr = r % I_DN; const int kb = rr / 32, n0 = 32 * (rr % 32);
                p0_transpose_item(ffn_w_down + (size_t)layer * FF * D, FF, D, nullptr, (bf16*)(ws + (layer ? WS_WDN1 : WS_WDN0)), kb, n0, n0, scr, lane); }
        }
        for (int m = gw; m < M; m += NGW) {
            const GAS f32x4* xr = (const GAS f32x4*)(x + (size_t)m * D) + lane; f32x4 v[4]; float s = 0.f;
#pragma unroll
            for (int j = 0; j < 4; ++j) { v[j] = __builtin_nontemporal_load(xr + 64 * j); s += (v[j].x * v[j].x + v[j].y * v[j].y) + (v[j].z * v[j].z + v[j].w * v[j].w); }
            s = wave_sum(s);
            GAS v2u* o8 = (GAS v2u*)(XB + (size_t)m * D) + lane;
#pragma unroll
            for (int j = 0; j < 4; ++j) { v2u o; o.x = pk2(v[j].x, v[j].y); o.y = pk2(v[j].z, v[j].w); __builtin_nontemporal_store(o, o8 + 64 * j); }
            if (lane == 0) *(GAS f32x4*)(STATS + (size_t)m * pg8::NSTAT) = (f32x4){s, 0.f, 0.f, 0.f};
        }
    }
    SEAM(0);
#if !MK_PER_PHASE
    if (IN(0) && IN(1)) {
        if (tid == 0) { unsigned ok = (G == 256) ? 1u : 0u, npop = 0u, xi = 0u;
            for (unsigned j = 0; j < 16; ++j) { const unsigned c = xb_ld(&bar.bar[XB_XCNT(j)]); if (c) { ok &= (c == 32u) ? 1u : 0u; ++npop; if (j < bar.x) ++xi; } }
            ok &= (npop == 8u) ? 1u : 0u;
            bst[3] = ok ? (0x10000u | (xi * 32u + bst[2])) : 0u; }
        __syncthreads();
    }
#endif
    if (IN(1)) {
        pg8::Gemm g{XB, Win_t, M, 3 * D, D}; pg8::StaticOrder S; S.init(M, 3 * D, G, CVID());
        FILL_RSL(S); pg8::EpiPair<2> E{CV, D, BG, (const LAS float*)(lds + RSL_OFF), nullptr};
        pg8::gemm_phase<pg8::EpiPair<2>, pg8::StaticOrder, true, true>(lds, g, S, E);
    }
    SEAM(1);
    if (IN(2)) {
        const int cg8 = tid & 127, sub = tid >> 7;
        float w0[8], w1[8], w2[8];
#pragma unroll
        for (int e = 0; e < 8; ++e) { w0[e] = a_conv[8 * cg8 + e]; w1[e] = a_conv[D + 8 * cg8 + e]; w2[e] = a_conv[2 * D + 8 * cg8 + e]; }
        constexpr int CH = 32;
        for (int chunk = VBLK() * 4 + sub; chunk < M / CH; chunk += G * 4) {
            const int t0 = chunk * CH; const bool first = (t0 & (SEQ - 1)) == 0;
            const GAS v4u* cvp = (const GAS v4u*)(CV + (size_t)t0 * D + 8 * cg8); const GAS v4u* bgp = (const GAS v4u*)(BG + (size_t)t0 * D + 8 * cg8); GAS v4u* yp = (GAS v4u*)(Y + (size_t)t0 * D + 8 * cg8);
            float p2[8], p1[8];
            { v4u a = (v4u){0u, 0u, 0u, 0u}, b = a; if (!first) { a = cvp[-2 * (D / 8)]; b = cvp[-1 * (D / 8)]; }
#pragma unroll
              for (int e = 0; e < 4; ++e) { p2[2 * e] = bf_lo(a[e]); p2[2 * e + 1] = bf_hi(a[e]); p1[2 * e] = bf_lo(b[e]); p1[2 * e + 1] = bf_hi(b[e]); } }
#pragma unroll 8
            for (int t = 0; t < CH; ++t) {
                const v4u c = __builtin_nontemporal_load(cvp + t * (D / 8)), bgv = __builtin_nontemporal_load(bgp + t * (D / 8)); float cur[8], o[8];
#pragma unroll
                for (int e = 0; e < 4; ++e) { cur[2 * e] = bf_lo(c[e]); cur[2 * e + 1] = bf_hi(c[e]); }
#pragma unroll
                for (int e = 0; e < 4; ++e) { o[2 * e] = bf_lo(bgv[e]) * (w0[2 * e] * p2[2 * e] + w1[2 * e] * p1[2 * e] + w2[2 * e] * cur[2 * e]);
                                              o[2 * e + 1] = bf_hi(bgv[e]) * (w0[2 * e + 1] * p2[2 * e + 1] + w1[2 * e + 1] * p1[2 * e + 1] + w2[2 * e + 1] * cur[2 * e + 1]); }
                v4u ov; ov.x = pk2(o[0], o[1]); ov.y = pk2(o[2], o[3]); ov.z = pk2(o[4], o[5]); ov.w = pk2(o[6], o[7]);
                yp[t * (D / 8)] = ov;
#pragma unroll
                for (int e = 0; e < 8; ++e) { p2[e] = p1[e]; p1[e] = cur[e]; }
            }
        }
    }
    SEAM(2);
    if (IN(3)) {
        pg8::Gemm g{Y, Wout_t, M, D, D}; pg8::StaticOrder S; S.init(M, D, G, CVID());
        pg8::EpiRes E{XB, STATS, nullptr, (LAS float*)(lds + RSL_OFF)};
        pg8::gemm_phase<pg8::EpiRes, pg8::StaticOrder, true, true>(lds, g, S, E);
    }
    SEAM(3);
    if (IN(4)) {
        pg8::Gemm g{XB, (const bf16*)(ws + WS_WGU0), M, 2 * FF, D}; pg8::StaticOrder S; S.init(M, 2 * FF, G, CVID());
        FILL_RSL(S); pg8::EpiPair<0> E{GU, FF, nullptr, (const LAS float*)(lds + RSL_OFF), nullptr};
        pg8::gemm_phase<pg8::EpiPair<0>, pg8::StaticOrder, true, true>(lds, g, S, E);
    }
    SEAM(4);
    if (IN(5)) {
        pg8::Gemm g{GU, (const bf16*)(ws + WS_WDN0), M, D, FF}; pg8::StaticOrder S; S.init(M, D, G, CVID());
        pg8::EpiRes E{XB, STATS, nullptr, (LAS float*)(lds + RSL_OFF)};
        pg8::gemm_phase<pg8::EpiRes, pg8::StaticOrder, true, true>(lds, g, S, E);
    }
    SEAM(5);
    if (IN(6)) {
        pg8::Gemm g{XB, Wpw1_t, M, 2 * D, D}; pg8::StaticOrder S; S.init(M, 2 * D, G, CVID());
        FILL_RSL(S); pg8::EpiPair<1> E{BG, D, nullptr, (const LAS float*)(lds + RSL_OFF), b_b_pw1};
        pg8::gemm_phase<pg8::EpiPair<1>, pg8::StaticOrder, true, true>(lds, g, S, E);
    }
    SEAM(6);
    if (IN(7)) {
        const int c0 = 2 * tid;
        f32x2 w[KCONF];
#pragma unroll
        for (int k = 0; k < KCONF; ++k) w[k] = *(const f32x2*)(b_conv + k * D + c0);
        const f32x2 cb = *(const f32x2*)(b_b_conv + c0);
        f32x4 lng4[4], lnb4[4];
#pragma unroll
        for (int j = 0; j < 4; ++j) { lng4[j] = *(const f32x4*)(b_ln_g + 4 * lane + 256 * j); lnb4[j] = *(const f32x4*)(b_ln_b + 4 * lane + 256 * j); }
        constexpr int TT = 16, NTILE = M / TT; const int per = (NTILE + G - 1) / G, tb = VBLK() * per, te = (tb + per < NTILE) ? tb + per : NTILE, nt_ = te - tb;
        unsigned xr[30 + TT];
        if (nt_ > 0) { const int t0 = tb * TT; const bool first = (t0 & (SEQ - 1)) == 0; const GAS unsigned* src = (const GAS unsigned*)(BG + (size_t)t0 * D + c0);
#pragma unroll
            for (int s = 0; s < 30 + TT; ++s) { const bool pad = first && s < 30; const unsigned u = src[(long)(pad ? 0 : s - 30) * (D / 2)]; xr[s] = pad ? 0u : u; } }
#define P7_CONV(i_) do { f32x2 acc[TT]; \
            _Pragma("unroll") for (int t = 0; t < TT; ++t) acc[t] = cb; \
            _Pragma("unroll") for (int s = 0; s < 30 + TT; ++s) { const f32x2 xv = (f32x2){bf_lo(xr[s]), bf_hi(xr[s])}; \
                _Pragma("unroll") for (int t = (s > 30 ? s - 30 : 0); t <= (s < TT ? s : TT - 1); ++t) acc[t] += w[s - t] * xv; } \
            LAS float* Tw = (LAS float*)(lds + ((i_) & 1) * 65536); \
            _Pragma("unroll") for (int t = 0; t < TT; ++t) *(LAS f32x2*)(Tw + t * D + c0) = acc[t]; } while (0)
#define P7_LN(i_) do { const LAS float* Tr = (const LAS float*)(lds + ((i_) & 1) * 65536); const int tbase = (tb + (i_)) * TT; \
            _Pragma("unroll") for (int q = 0; q < 2; ++q) { const int t = wave * 2 + q; f32x4 v[4]; float s = 0.f, s2 = 0.f; \
                _Pragma("unroll") for (int j = 0; j < 4; ++j) { v[j] = *(const LAS f32x4*)(Tr + t * D + 4 * lane + 256 * j); s += (v[j].x + v[j].y) + (v[j].z + v[j].w); s2 += (v[j].x * v[j].x + v[j].y * v[j].y) + (v[j].z * v[j].z + v[j].w * v[j].w); } \
                const float mean = wave_sum(s) * (1.f / D); const float var = fmaxf(wave_sum(s2) * (1.f / D) - mean * mean, 0.f); \
                const float rstd = 1.f / sqrtf(var + LN_EPS); \
                GAS v2u* o8 = (GAS v2u*)(CV + (size_t)(tbase + t) * D) + lane; \
                _Pragma("unroll") for (int j = 0; j < 4; ++j) { const f32x4 gg = lng4[j], bb = lnb4[j]; \
                    f32x4 y = (v[j] - mean) * rstd * gg + bb; y.x *= sigm(y.x); y.y *= sigm(y.y); y.z *= sigm(y.z); y.w *= sigm(y.w); \
                    v2u o; o.x = pk2(y.x, y.y); o.y = pk2(y.z, y.w); o8[64 * j] = o; } } } while (0)
        for (int i = 0; i <= nt_; ++i) {
            unsigned xn[TT];
            if (i + 1 < nt_) { const GAS unsigned* src = (const GAS unsigned*)(BG + (size_t)((tb + i + 1) * TT) * D + c0);
#pragma unroll
                for (int s = 0; s < TT; ++s) xn[s] = __builtin_nontemporal_load(src + (long)s * (D / 2)); }
            else {
#pragma unroll
                for (int s = 0; s < TT; ++s) xn[s] = 0u; }
            if (i == 0) { P7_CONV(i); }
            else if (i == nt_) { P7_LN(i - 1); }
            else if (wave < 4) { P7_CONV(i); P7_LN(i - 1); }
            else { P7_LN(i - 1); P7_CONV(i); }
            __syncthreads();
            const bool nfirst = (((tb + i + 1) * TT) & (SEQ - 1)) == 0;
#pragma unroll
            for (int s = 0; s < 30; ++s) xr[s] = nfirst ? 0u : xr[s + TT];
#pragma unroll
            for (int s = 0; s < TT; ++s) xr[30 + s] = xn[s];
        }
#undef P7_CONV
#undef P7_LN
    }
    SEAM(7);
    if (IN(8)) {
        pg8::Gemm g{CV, Wpw2_t, M, D, D}; pg8::StaticOrder S; S.init(M, D, G, CVID());
        pg8::EpiRes E{XB, STATS, b_b_pw2, (LAS float*)(lds + RSL_OFF)};
        pg8::gemm_phase<pg8::EpiRes, pg8::StaticOrder, true, true>(lds, g, S, E);
    }
    SEAM(8);
    if (IN(9)) {
        pg8::Gemm g{XB, (const bf16*)(ws + WS_WGU1), M, 2 * FF, D}; pg8::StaticOrder S; S.init(M, 2 * FF, G, CVID());
        FILL_RSL(S); pg8::EpiPair<0> E{GU, FF, nullptr, (const LAS float*)(lds + RSL_OFF), nullptr};
        pg8::gemm_phase<pg8::EpiPair<0>, pg8::StaticOrder, true, true>(lds, g, S, E);
    }
    SEAM(9);
    if (IN(10)) {
        pg8::Gemm g{GU, (const bf16*)(ws + WS_WDN1), M, D, FF}; pg8::StaticOrder S; S.init(M, D, G, CVID());
        pg8::EpiRes E{XB, STATS, nullptr, (LAS float*)(lds + RSL_OFF)};
        pg8::gemm_phase<pg8::EpiRes, pg8::StaticOrder, true, true>(lds, g, S, E);
    }
    SEAM(10);
    if (IN(11)) {
        const int gw = bid * NWAVES + wave, NGW = G * NWAVES;
        f32x4 gn[4];
#pragma unroll
        for (int j = 0; j < 4; ++j) gn[j] = *(const f32x4*)(final_norm + 4 * lane + 256 * j);
        const int vblk11 = VBLK();
        for (int mi = 0; mi < (M / 128 + G - 1) / G * 16; ++mi) { const int blk_ = vblk11 + (mi >> 4) * G; if (blk_ >= M / 128) break; const int m = blk_ * 128 + wave * 16 + (mi & 15);
            const GAS v2u* hr = (const GAS v2u*)(XB + (size_t)m * D) + lane; v2u hv[4];
#pragma unroll
            for (int j = 0; j < 4; ++j) hv[j] = __builtin_nontemporal_load(hr + 64 * j);
            float s = lane < pg8::NSTAT ? STATS[(size_t)m * pg8::NSTAT + lane] : 0.f;
            s += __shfl_xor(s, 1); s += __shfl_xor(s, 2);
            const float r = 1.f / sqrtf(__shfl(s, 0) * (1.f / D) + RMS_EPS);
            GAS f32x4* orow = (GAS f32x4*)(out + (size_t)m * D) + lane;
#pragma unroll
            for (int j = 0; j < 4; ++j) { const f32x4 v = (f32x4){bf_lo(hv[j].x), bf_hi(hv[j].x), bf_lo(hv[j].y), bf_hi(hv[j].y)}; __builtin_nontemporal_store(v * r * gn[j], orow + 64 * j); }
        }
    }
#undef IN
#undef SEAM
}

extern "C" void kernel_launch(void* const* d_in, const int* in_sizes, int n_in, void* d_out, int out_size, void* d_ws, size_t ws_size, hipStream_t stream) {
    static int grid = 0;
    if (grid == 0) {
        if (n_in != 19 || in_sizes[0] != M * D || out_size != M * D || ws_size < WS_END) { fprintf(stderr, "kernel_launch: shape/workspace mismatch: n_in %d in0 %d out %d ws %zu (need %zu); nothing launched\n", n_in, n_in > 0 ? in_sizes[0] : -1, out_size, ws_size, (size_t)WS_END); grid = -1; return; }
        int dev = 0, cus = 0, per_cu = 0;
        if (hipGetDevice(&dev) != hipSuccess || hipDeviceGetAttribute(&cus, hipDeviceAttributeMultiprocessorCount, dev) != hipSuccess) { fprintf(stderr, "kernel_launch: device query failed\n"); grid = -1; return; }
        if (hipFuncSetAttribute((const void*)trunk_fwd, hipFuncAttributeMaxDynamicSharedMemorySize, LDS_BYTES) != hipSuccess) { fprintf(stderr, "kernel_launch: hipFuncSetAttribute failed\n"); grid = -1; return; }
        if (hipOccupancyMaxActiveBlocksPerMultiprocessor(&per_cu, (const void*)trunk_fwd, NTHR, LDS_BYTES) != hipSuccess || per_cu < 1) { fprintf(stderr, "kernel_launch: occupancy query says %d blocks/CU; using 1\n", per_cu); per_cu = 1; }
        (void)hipGetLastError();
        grid = cus * per_cu;
    }
    if (grid < 0) return;
    Args a{};
    for (int i = 0; i < 19; ++i) a.in[i] = (const float*)d_in[i];
    a.out = (float*)d_out; a.ws = (unsigned char*)d_ws;
#if MK_PER_PHASE
    for (int p = 0; p < NPHASE; ++p) { a.ph_lo = p; a.ph_hi = p + 1; hipLaunchKernelGGL(trunk_fwd, dim3(grid), dim3(NTHR), LDS_BYTES, stream, a); }
#else
    a.ph_lo = 0; a.ph_hi = NPHASE;
    if (hipMemsetAsync(d_ws, 0, 16384, stream) != hipSuccess) { fprintf(stderr, "kernel_launch: memset of the barrier words failed\n"); return; }
    void* kargs[] = {&a};
    hipError_t e = hipLaunchCooperativeKernel((const void*)trunk_fwd, dim3(grid), dim3(NTHR), kargs, LDS_BYTES, stream);
    if (e != hipSuccess) fprintf(stderr, "kernel_launch: cooperative launch failed: %s (grid %d)\n", hipGetErrorString(e), grid);
#if MK_PROBE_PHASE >= 0
    a.ph_lo = MK_PROBE_PHASE; a.ph_hi = MK_PROBE_PHASE + 1; hipLaunchKernelGGL(trunk_fwd, dim3(grid), dim3(NTHR), LDS_BYTES, stream, a);
#endif
#endif
}
```
